# Optimizing an MI355X kernel written in HIP

```python
import jax, jax.numpy as jnp
from jax import lax
import numpy as np

D_MODEL = 1024
BATCH = 4
SEQ = 4096
DEPTH = 2

CHUNK = 64
N_A_LAYERS = DEPTH // 2
N_B_LAYERS = DEPTH - N_A_LAYERS
EPS = 1e-6
SGU_BLOCK = 128
SGU_WIDTH = 2 * D_MODEL
SGU_GROUPS = 8
SGU_GROUP_DIM = SGU_WIDTH // SGU_GROUPS
N_HEADS = 16
HEAD_DIM = D_MODEL // N_HEADS
Q_BLOCK = 128
N_GROUPS = 4
EXPERTS_PER_GROUP = 8
N_EXPERTS = N_GROUPS * EXPERTS_PER_GROUP
TOP_K = 2
D_EXPERT = D_MODEL // 2
EXPERT_BLOCK = 128

kernel_name = "yoco_gmlp_fox_hmoe_trunk"


def rmsnorm(x, g):
    xf = x.astype(jnp.float32)
    y = xf * lax.rsqrt(jnp.mean(xf * xf, axis=-1, keepdims=True) + EPS)
    return (y * g.astype(jnp.float32)).astype(x.dtype)


def sgu_mixer(h, w_in, b_in, v_norm, w_s, b_s, w_out):
    B, S, _ = h.shape
    z = jax.nn.gelu(h @ w_in + b_in)
    u, v = jnp.split(z, 2, axis=-1)
    v = rmsnorm(v, v_norm)
    nb = S // SGU_BLOCK
    v = v.reshape(B, nb, SGU_BLOCK, SGU_GROUPS, SGU_GROUP_DIM)
    chunk_id = jnp.arange(SGU_BLOCK) // CHUNK
    mask = chunk_id[:, None] >= chunk_id[None, :]
    w_sm = jnp.where(mask[None], w_s, jnp.zeros_like(w_s))
    v = jnp.einsum('gts,bnsgc->bntgc', w_sm, v) + b_s.T[None, None, :, :, None]
    gated = u * v.reshape(B, S, SGU_WIDTH)
    return gated @ w_out


def shared_kv(x_kv, kv_norm, kv_w, kv_b_f, k_norm):
    B, S, _ = x_kv.shape
    h = rmsnorm(x_kv, kv_norm)
    kvf = h @ kv_w
    k, v, f = jnp.split(kvf, [D_MODEL, 2 * D_MODEL], axis=-1)
    k = rmsnorm(k.reshape(B, S, N_HEADS, HEAD_DIM), k_norm)
    v = v.reshape(B, S, N_HEADS, HEAD_DIM)
    log_f = jax.nn.log_sigmoid((f + kv_b_f).astype(jnp.float32))
    cum = jnp.cumsum(log_f, axis=1).transpose(0, 2, 1)
    return k, v, cum


def forgetting_attention(h, k, v, cum, w_qg, q_norm, w_out):
    B, S, _ = h.shape
    q, gate = jnp.split(h @ w_qg, 2, axis=-1)
    q = rmsnorm(q.reshape(B, S, N_HEADS, HEAD_DIM), q_norm)
    scale = HEAD_DIM ** -0.5
    outs = []
    for i in range(S // Q_BLOCK):
        q0, q1 = i * Q_BLOCK, (i + 1) * Q_BLOCK
        kb, vb = k[:, :q1], v[:, :q1]
        s = jnp.einsum('bqhd,bkhd->bhqk', q[:, q0:q1], kb).astype(jnp.float32) * scale
        decay = cum[:, :, q0:q1, None] - cum[:, :, None, :q1]
        mask = (q0 + jnp.arange(Q_BLOCK))[:, None] >= jnp.arange(q1)[None, :]
        s = jnp.where(mask, s + decay, -jnp.inf)
        p = jax.nn.softmax(s, axis=-1)
        outs.append(jnp.einsum('bhqk,bkhd->bqhd', p.astype(vb.dtype), vb))
    o = jnp.concatenate(outs, axis=1).reshape(B, S, D_MODEL)
    return (o * jax.nn.sigmoid(gate)) @ w_out


def hierarchical_moe(h, w_group, b_group, w_expert, b_expert, w1, w3, w2):
    B, S, D = h.shape
    T = B * S
    xf = h.reshape(T, D)
    tok = jnp.arange(T)
    g_logits = (xf @ w_group + b_group).astype(jnp.float32)
    g_prob = jax.nn.softmax(g_logits, axis=-1)
    g_sel = jnp.argmax(g_logits, axis=-1).astype(jnp.int32)
    g_w = g_prob[tok, g_sel][:, None]
    e_logits = (xf @ w_expert + b_expert).astype(jnp.float32)
    e_logits = e_logits.reshape(T, N_GROUPS, EXPERTS_PER_GROUP)[tok, g_sel]
    e_prob = jax.nn.softmax(e_logits, axis=-1)
    top_p, top_i = lax.top_k(e_prob, TOP_K)
    top_p = top_p / jnp.sum(top_p, axis=-1, keepdims=True)
    weights = g_w * top_p
    expert_id = g_sel[:, None] * EXPERTS_PER_GROUP + top_i.astype(jnp.int32)
    A = T * TOP_K
    flat_e = expert_id.reshape(A)
    flat_tok = jnp.arange(A, dtype=jnp.int32) // TOP_K
    flat_w = weights.reshape(A)
    order = jnp.argsort(flat_e)
    sorted_e = flat_e[order]
    counts = jnp.zeros((N_EXPERTS,), jnp.int32).at[flat_e].add(1)
    padded = (counts + EXPERT_BLOCK - 1) // EXPERT_BLOCK * EXPERT_BLOCK
    start = jnp.cumsum(counts) - counts
    pend = jnp.cumsum(padded)
    pstart = pend - padded
    dest = pstart[sorted_e] + (jnp.arange(A, dtype=jnp.int32) - start[sorted_e])
    n_blocks = -(-A // EXPERT_BLOCK) + N_EXPERTS
    n_rows = n_blocks * EXPERT_BLOCK
    tok_buf = jnp.full((n_rows,), T, jnp.int32).at[dest].set(flat_tok[order])
    w_buf = jnp.zeros((n_rows,), jnp.float32).at[dest].set(flat_w[order])
    block_start = jnp.arange(n_blocks, dtype=jnp.int32) * EXPERT_BLOCK
    block_e = jnp.minimum(jnp.searchsorted(pend, block_start, side='right'),
                          N_EXPERTS - 1).astype(jnp.int32)
    x_pad = jnp.concatenate([xf, jnp.zeros((1, D), xf.dtype)], axis=0)
    xs = x_pad[tok_buf].reshape(n_blocks, EXPERT_BLOCK, D)

    def expert_block(args):
        xb, e = args
        hid = jax.nn.silu(xb @ w1[e]) * (xb @ w3[e])
        return hid @ w2[e]

    ys = lax.map(expert_block, (xs, block_e)).reshape(n_rows, D)
    ys = ys * w_buf[:, None].astype(ys.dtype)
    out = jnp.zeros((T + 1, D), ys.dtype).at[tok_buf].add(ys)[:T]
    return out.reshape(B, S, D)


def setup_inputs(seed: int = 0) -> dict:
    key = jax.random.key(seed)
    ks = jax.random.split(key, 32)

    def nrm(k, shape, scale):
        return jax.random.normal(k, shape, jnp.float32) * scale

    def gain(k, shape):
        return 1.0 + 0.02 * jax.random.normal(k, shape, jnp.float32)

    NA, NB, L = N_A_LAYERS, N_B_LAYERS, DEPTH
    return {
        "x": nrm(ks[0], (BATCH, SEQ, D_MODEL), 1.0),
        "a_norm": gain(ks[1], (NA, D_MODEL)),
        "a_w_in": nrm(ks[2], (NA, D_MODEL, 2 * SGU_WIDTH), D_MODEL ** -0.5),
        "a_b_in": nrm(ks[3], (NA, 2 * SGU_WIDTH), 0.01),
        "a_v_norm": gain(ks[4], (NA, SGU_WIDTH)),
        "a_w_s": nrm(ks[5], (NA, SGU_GROUPS, SGU_BLOCK, SGU_BLOCK), SGU_BLOCK ** -0.5),
        "a_b_s": gain(ks[6], (NA, SGU_GROUPS, SGU_BLOCK)),
        "a_w_out": nrm(ks[7], (NA, SGU_WIDTH, D_MODEL), SGU_WIDTH ** -0.5),
        "kv_norm": gain(ks[8], (D_MODEL,)),
        "kv_w": nrm(ks[9], (D_MODEL, 2 * D_MODEL + N_HEADS), D_MODEL ** -0.5),
        "kv_b_f": nrm(ks[10], (N_HEADS,), 0.01),
        "k_norm": gain(ks[11], (HEAD_DIM,)),
        "b_norm": gain(ks[12], (NB, D_MODEL)),
        "b_w_qg": nrm(ks[13], (NB, D_MODEL, 2 * D_MODEL), D_MODEL ** -0.5),
        "q_norm": gain(ks[14], (NB, HEAD_DIM)),
        "b_w_out": nrm(ks[15], (NB, D_MODEL, D_MODEL), D_MODEL ** -0.5),
        "m_norm": gain(ks[16], (L, D_MODEL)),
        "m_w_group": nrm(ks[17], (L, D_MODEL, N_GROUPS), D_MODEL ** -0.5),
        "m_b_group": nrm(ks[18], (L, N_GROUPS), 0.01),
        "m_w_expert": nrm(ks[19], (L, D_MODEL, N_EXPERTS), D_MODEL ** -0.5),
        "m_b_expert": nrm(ks[20], (L, N_EXPERTS), 0.01),
        "m_w1": nrm(ks[21], (L, N_EXPERTS, D_MODEL, D_EXPERT), D_MODEL ** -0.5),
        "m_w3": nrm(ks[22], (L, N_EXPERTS, D_MODEL, D_EXPERT), D_MODEL ** -0.5),
        "m_w2": nrm(ks[23], (L, N_EXPERTS, D_EXPERT, D_MODEL), D_EXPERT ** -0.5),
    }


def reference(x, a_norm, a_w_in, a_b_in, a_v_norm, a_w_s, a_b_s, a_w_out,
              kv_norm, kv_w, kv_b_f, k_norm,
              b_norm, b_w_qg, q_norm, b_w_out,
              m_norm, m_w_group, m_b_group, m_w_expert, m_b_expert, m_w1, m_w3, m_w2):
    k = v = cum = None
    for layer in range(DEPTH):
        if layer < N_A_LAYERS:
            i = layer
            x = x + sgu_mixer(rmsnorm(x, a_norm[i]), a_w_in[i], a_b_in[i], a_v_norm[i],
                              a_w_s[i], a_b_s[i], a_w_out[i])
        else:
            if layer == N_A_LAYERS:
                k, v, cum = shared_kv(x, kv_norm, kv_w, kv_b_f, k_norm)
            j = layer - N_A_LAYERS
            x = x + forgetting_attention(rmsnorm(x, b_norm[j]), k, v, cum,
                                         b_w_qg[j], q_norm[j], b_w_out[j])
        x = x + hierarchical_moe(rmsnorm(x, m_norm[layer]), m_w_group[layer], m_b_group[layer],
                                 m_w_expert[layer], m_b_expert[layer],
                                 m_w1[layer], m_w3[layer], m_w2[layer])
    return x
```

```cpp
#include <hip/hip_runtime.h>
#include <cstdint>
#include <cmath>

namespace nv {
constexpr int D = 1024, NB = 4, S = 4096, T = NB * S, SW = 2048, ZW = 4096, H = 16, HD = 64, NG = 4, EPG = 8, NE = 32, DE = 512, KVW = 2 * D + H;
constexpr float EPS = 1e-6f;

__global__ void rmsnorm(const float* x, int ldx, const float* g, float* y, int ldy, int W) {
    const int r = blockIdx.x; const float* xr = x + (size_t)r * ldx;
    float s = 0.f; for (int c = threadIdx.x; c < W; c += 256) { const float v = xr[c]; s += v * v; }
    __shared__ float red[256]; red[threadIdx.x] = s; __syncthreads();
    for (int o = 128; o > 0; o >>= 1) { if ((int)threadIdx.x < o) red[threadIdx.x] += red[threadIdx.x + o]; __syncthreads(); }
    const float rs = rsqrtf(red[0] / (float)W + EPS);
    for (int c = threadIdx.x; c < W; c += 256) y[(size_t)r * ldy + c] = xr[c] * rs * g[c];
}
__global__ void headnorm(float* x, int ld, const float* g) {
    const int r = blockIdx.x, c = threadIdx.x; float v = x[(size_t)r * ld + c]; float s = v * v;
    for (int o = 1; o < 64; o <<= 1) s += __shfl_xor(s, o);
    x[(size_t)r * ld + c] = v * rsqrtf(s / 64.f + EPS) * g[c & 63];
}
__device__ __forceinline__ float gelu_tanh(float v) { return 0.5f * v * (1.f + tanhf(0.7978845608028654f * (v + 0.044715f * v * v * v))); }
template <int MODE> __global__ void gemm(const float* A, int lda, const float* Bm, int ldb, float* C, int ldc, const float* bias, const float* R, int ldr, int M, int N, int K) {
    __shared__ float As[16][68], Bs[16][68];
    const int tx = threadIdx.x % 16, ty = threadIdx.x / 16, m0 = blockIdx.y * 64, n0 = blockIdx.x * 64;
    float acc[4][4] = {};
    for (int k0 = 0; k0 < K; k0 += 16) {
        for (int i = threadIdx.x; i < 1024; i += 256) { const int m = i / 16, k = i % 16; As[k][m] = A[(size_t)(m0 + m) * lda + k0 + k]; }
        for (int i = threadIdx.x; i < 1024; i += 256) { const int k = i / 64, n = i % 64; Bs[k][n] = (n0 + n < N) ? Bm[(size_t)(k0 + k) * ldb + n0 + n] : 0.f; }
        __syncthreads();
#pragma unroll
        for (int k = 0; k < 16; ++k) {
            float a[4], b[4];
#pragma unroll
            for (int i = 0; i < 4; ++i) { a[i] = As[k][ty * 4 + i]; b[i] = Bs[k][tx * 4 + i]; }
#pragma unroll
            for (int i = 0; i < 4; ++i)
#pragma unroll
                for (int j = 0; j < 4; ++j) acc[i][j] += a[i] * b[j];
        }
        __syncthreads();
    }
    for (int i = 0; i < 4; ++i) for (int j = 0; j < 4; ++j) {
        const int m = m0 + ty * 4 + i, n = n0 + tx * 4 + j; if (n >= N) continue;
        float v = acc[i][j]; if (bias) v += bias[n]; if (MODE == 1) v = gelu_tanh(v); if (MODE == 2) v += R[(size_t)m * ldr + n];
        C[(size_t)m * ldc + n] = v;
    }
}
__global__ void sgu(const float* z, const float* w_s, const float* b_s, float* gated) {
    const int c = blockIdx.x * 256 + threadIdx.x, t = blockIdx.y, g = c / 256, blk = t / 128, tt = t % 128;
    const float* W = w_s + ((size_t)g * 128 + tt) * 128; float acc = 0.f; const int smax = (tt < 64) ? 64 : 128;
    for (int s = 0; s < smax; ++s) acc += W[s] * z[(size_t)(blk * 128 + s) * ZW + SW + c];
    gated[(size_t)t * SW + c] = z[(size_t)t * ZW + c] * (acc + b_s[g * 128 + tt]);
}
__global__ void route(const float* xn, const float* wg, const float* bg, const float* we, const float* be, int* eid, float* ew) {
    const int t = blockIdx.x, l = threadIdx.x; __shared__ float part[64][37]; __shared__ float lg[36];
    float a[36]; for (int j = 0; j < 36; ++j) a[j] = 0.f;
    for (int k = l; k < D; k += 64) { const float xv = xn[(size_t)t * D + k];
        for (int j = 0; j < 32; ++j) a[j] += xv * we[(size_t)k * NE + j];
        for (int j = 0; j < 4; ++j) a[32 + j] += xv * wg[(size_t)k * NG + j]; }
    for (int j = 0; j < 36; ++j) part[l][j] = a[j];
    __syncthreads();
    if (l < 36) { float s = 0.f; for (int i = 0; i < 64; ++i) s += part[i][l]; lg[l] = s + (l < 32 ? be[l] : bg[l - 32]); }
    __syncthreads();
    if (l == 0) {
        int gs = 0; float gm = lg[32]; for (int j = 1; j < 4; ++j) if (lg[32 + j] > gm) { gm = lg[32 + j]; gs = j; }
        float gsum = 0.f; for (int j = 0; j < 4; ++j) gsum += expf(lg[32 + j] - gm); const float gw = 1.f / gsum;
        const float* el = lg + gs * EPG; int i0 = 0; for (int j = 1; j < EPG; ++j) if (el[j] > el[i0]) i0 = j;
        int i1 = (i0 == 0) ? 1 : 0; for (int j = 0; j < EPG; ++j) if (j != i0 && el[j] > el[i1]) i1 = j;
        const float p1 = expf(el[i1] - el[i0]); const float w0 = 1.f / (1.f + p1), w1 = p1 / (1.f + p1);
        eid[2 * t] = gs * EPG + i0; eid[2 * t + 1] = gs * EPG + i1; ew[2 * t] = gw * w0; ew[2 * t + 1] = gw * w1;
    }
}
__global__ void moe_ffn(const float* xn, const float* xres, const int* eid, const float* ew, const float* w1, const float* w3, const float* w2, float* out) {
    __shared__ float xs[1024], hs[512]; const int t = blockIdx.x, tid = threadIdx.x;
    for (int i = tid; i < D; i += 256) xs[i] = xn[(size_t)t * D + i];
    float o[4] = {0.f, 0.f, 0.f, 0.f}; __syncthreads();
    for (int k = 0; k < 2; ++k) { const int e = eid[2 * t + k]; const float w = ew[2 * t + k];
        const float* W1 = w1 + (size_t)e * D * DE; const float* W3 = w3 + (size_t)e * D * DE; const float* W2 = w2 + (size_t)e * DE * D;
        for (int j = tid; j < DE; j += 256) { float a = 0.f, b = 0.f; for (int kk = 0; kk < D; ++kk) { a += xs[kk] * W1[(size_t)kk * DE + j]; b += xs[kk] * W3[(size_t)kk * DE + j]; }
            hs[j] = a / (1.f + expf(-a)) * b; }
        __syncthreads();
        for (int i = 0; i < 4; ++i) { const int n = tid + 256 * i; float y = 0.f; for (int j = 0; j < DE; ++j) y += hs[j] * W2[(size_t)j * D + n]; o[i] += w * y; }
        __syncthreads(); }
    for (int i = 0; i < 4; ++i) { const int n = tid + 256 * i; out[(size_t)t * D + n] = xres[(size_t)t * D + n] + o[i]; }
}
__global__ void logf_k(const float* kvf, const float* bf, float* lf) {
    const int i = blockIdx.x * 256 + threadIdx.x, t = i / H, h = i % H; const float f = kvf[(size_t)t * KVW + 2 * D + h] + bf[h];
    lf[i] = fminf(f, 0.f) - log1pf(expf(-fabsf(f)));
}
__global__ void cumsum_k(const float* lf, float* cum) {
    const int h = threadIdx.x; if (h >= H) return; double s = 0.0; for (int t = 0; t < S; ++t) { s += (double)lf[t * H + h]; cum[h * S + t] = (float)s; }
}
__global__ void attn(const float* qg, const float* kvf, const float* cum, float* ao) {
    const int t = blockIdx.x, h = blockIdx.y, d = threadIdx.x; const float qd = qg[(size_t)t * 2 * D + h * HD + d]; const float ct = cum[h * S + t];
    float m = -INFINITY, l = 0.f, acc = 0.f;
    for (int s = 0; s <= t; ++s) { float p = qd * kvf[(size_t)s * KVW + h * HD + d];
        for (int o = 1; o < 64; o <<= 1) p += __shfl_xor(p, o);
        const float sc = p * 0.125f + ct - cum[h * S + s]; const float mn = fmaxf(m, sc), f = expf(m - mn), e = expf(sc - mn);
        l = l * f + e; acc = acc * f + e * kvf[(size_t)s * KVW + D + h * HD + d]; m = mn; }
    const float gt = qg[(size_t)t * 2 * D + D + h * HD + d];
    ao[(size_t)t * D + h * HD + d] = acc / l / (1.f + expf(-gt));
}
}

extern "C" void kernel_launch(void* const* d_in, const int* in_sizes, int n_in, void* d_out, int out_size, void* d_ws, size_t ws_size, hipStream_t stream) {
    using namespace nv;
    const float* x = (const float*)d_in[0]; const float* a_norm = (const float*)d_in[1]; const float* a_w_in = (const float*)d_in[2]; const float* a_b_in = (const float*)d_in[3];
    const float* a_v_norm = (const float*)d_in[4]; const float* a_w_s = (const float*)d_in[5]; const float* a_b_s = (const float*)d_in[6]; const float* a_w_out = (const float*)d_in[7];
    const float* kv_norm = (const float*)d_in[8]; const float* kv_w = (const float*)d_in[9]; const float* kv_b_f = (const float*)d_in[10]; const float* k_norm = (const float*)d_in[11];
    const float* b_norm = (const float*)d_in[12]; const float* b_w_qg = (const float*)d_in[13]; const float* q_norm = (const float*)d_in[14]; const float* b_w_out = (const float*)d_in[15];
    const float* m_norm = (const float*)d_in[16]; const float* m_w_group = (const float*)d_in[17]; const float* m_b_group = (const float*)d_in[18]; const float* m_w_expert = (const float*)d_in[19];
    const float* m_b_expert = (const float*)d_in[20]; const float* m_w1 = (const float*)d_in[21]; const float* m_w3 = (const float*)d_in[22]; const float* m_w2 = (const float*)d_in[23];
    float* out = (float*)d_out; char* ws = (char*)d_ws; const size_t MiB = 1u << 20;
    float* hbuf = (float*)(ws + 0 * MiB);
    float* z = (float*)(ws + 16 * MiB);
    float* gated = (float*)(ws + 80 * MiB);
    float* kvf = (float*)(ws + 112 * MiB);
    float* qg = (float*)(ws + 146 * MiB);
    float* ao = (float*)(ws + 178 * MiB);
    float* lf = (float*)(ws + 194 * MiB);
    float* cum = (float*)(ws + 195 * MiB);
    int* eid = (int*)(ws + 196 * MiB); float* ew = (float*)(ws + 197 * MiB);
    for (int b = 0; b < NB; ++b) {
        const float* xb = x + (size_t)b * S * D; float* ob = out + (size_t)b * S * D;
        rmsnorm<<<S, 256, 0, stream>>>(xb, D, a_norm, hbuf, D, D);
        gemm<1><<<dim3(ZW / 64, S / 64), 256, 0, stream>>>(hbuf, D, a_w_in, ZW, z, ZW, a_b_in, nullptr, 0, S, ZW, D);
        rmsnorm<<<S, 256, 0, stream>>>(z + SW, ZW, a_v_norm, z + SW, ZW, SW);
        sgu<<<dim3(SW / 256, S), 256, 0, stream>>>(z, a_w_s, a_b_s, gated);
        gemm<2><<<dim3(D / 64, S / 64), 256, 0, stream>>>(gated, SW, a_w_out, D, ob, D, nullptr, xb, D, S, D, SW);
        rmsnorm<<<S, 256, 0, stream>>>(ob, D, m_norm, hbuf, D, D);
        route<<<S, 64, 0, stream>>>(hbuf, m_w_group, m_b_group, m_w_expert, m_b_expert, eid, ew);
        moe_ffn<<<S, 256, 0, stream>>>(hbuf, ob, eid, ew, m_w1, m_w3, m_w2, ob);
        rmsnorm<<<S, 256, 0, stream>>>(ob, D, kv_norm, hbuf, D, D);
        gemm<0><<<dim3((KVW + 63) / 64, S / 64), 256, 0, stream>>>(hbuf, D, kv_w, KVW, kvf, KVW, nullptr, nullptr, 0, S, KVW, D);
        headnorm<<<S, 1024, 0, stream>>>(kvf, KVW, k_norm);
        logf_k<<<S * H / 256, 256, 0, stream>>>(kvf, kv_b_f, lf);
        cumsum_k<<<1, 64, 0, stream>>>(lf, cum);
        rmsnorm<<<S, 256, 0, stream>>>(ob, D, b_norm, hbuf, D, D);
        gemm<0><<<dim3(2 * D / 64, S / 64), 256, 0, stream>>>(hbuf, D, b_w_qg, 2 * D, qg, 2 * D, nullptr, nullptr, 0, S, 2 * D, D);
        headnorm<<<S, 1024, 0, stream>>>(qg, 2 * D, q_norm);
        attn<<<dim3(S, H), 64, 0, stream>>>(qg, kvf, cum, ao);
        gemm<2><<<dim3(D / 64, S / 64), 256, 0, stream>>>(ao, D, b_w_out, D, ob, D, nullptr, ob, D, S, D, D);
        rmsnorm<<<S, 256, 0, stream>>>(ob, D, m_norm + D, hbuf, D, D);
        route<<<S, 64, 0, stream>>>(hbuf, m_w_group + D * NG, m_b_group + NG, m_w_expert + D * NE, m_b_expert + NE, eid, ew);
        moe_ffn<<<S, 256, 0, stream>>>(hbuf, ob, eid, ew, m_w1 + (size_t)NE * D * DE, m_w3 + (size_t)NE * D * DE, m_w2 + (size_t)NE * DE * D, ob);
    }
}
```

```cpp
#include <hip/hip_bf16.h>
#include <cmath>
#include <hip/hip_runtime.h>

#include <cstdint>


#ifndef DBG
#define DBG 0
#endif
#if DBG
#define MK_PER_PHASE 1
#endif
#ifndef MK_PER_PHASE
#define MK_PER_PHASE 0
#endif
#ifndef DBG_AFTER_PHASE
#define DBG_AFTER_PHASE(p) do { } while (0)
#endif

constexpr int D = 1024, NB = 4, S = 4096, T = NB * S, SW = 2048, ZW = 4096, H = 16, HD = 64, NG = 4, EPG = 8, NE = 32, DE = 512, KVW = 2 * D + H;
constexpr int LCAP = 16384;
constexpr int HID_ROWS = 2 * T + NE * 256;
constexpr float EPS = 1e-6f;
constexpr float LOG2E = 1.4426950408889634f;

#define LAS __attribute__((address_space(3)))
#define GAS __attribute__((address_space(1)))

namespace pg8 {
#define PG8_LAS __attribute__((address_space(3)))
typedef unsigned short bf16_t;
typedef short bf16x8 __attribute__((ext_vector_type(8)));
typedef float f32x4 __attribute__((ext_vector_type(4)));
typedef float f32x2 __attribute__((ext_vector_type(2)));
typedef unsigned u32x4 __attribute__((ext_vector_type(4)));
typedef unsigned u32x2 __attribute__((ext_vector_type(2)));
constexpr int BM = 256, BK = 64, HALF = 128, HTB = HALF * BK * 2  , STAGE_BYTES = 8 * HTB, NXCD = 8, WGM = 8;

__host__ __device__ __forceinline__ int lds_byte(int r, int c) { const int st = (r >> 4) * 2 + (c >> 5), rr = r & 15, cc = c & 31, ob = rr * 64 + cc * 2; return st * 1024 + (ob ^ (((ob >> 9) & 1) << 5)); }
__host__ __device__ __forceinline__ void stage_rc(int b, int& R, int& C) { const int st = b / 1024, sb = b % 1024, swz = sb ^ (((sb >> 9) & 1) << 5); R = (st >> 1) * 16 + swz / 64; C = (st & 1) * 32 + (swz % 64) / 2; }
__host__ __device__ __forceinline__ int perm32(int rho) { const int n = rho >> 4, i = rho & 15; return 8 * (i >> 2) + 4 * n + (i & 3); }

struct Unit { int pm, pn, e, slot, hrow0; };

struct DenseOrder {
    int nM, nN, nwg, G, c;
    __device__ void init(int M, int N, int G_, int c_) { nM = M / BM; nN = N / BM; nwg = nM * nN; G = G_; c = c_; }
    __device__ bool next(int i, Unit& u) const {
        const long L = (long)i * G + c; if (L >= nwg) return false;
        int wgid = (int)L; { const int q = nwg / NXCD, r = nwg % NXCD, xcd = wgid % NXCD, off = wgid / NXCD; wgid = (xcd < r ? xcd * (q + 1) : r * (q + 1) + (xcd - r) * q) + off; }
        const int nig = WGM * nN, gid = wgid / nig, fm = gid * WGM, gsz = (nM - fm) < WGM ? (nM - fm) : WGM;
        u.pm = fm + ((wgid % nig) % gsz); u.pn = (wgid % nig) / gsz; u.e = 0; u.slot = 0; u.hrow0 = 0; return true;
    }
    __device__ __forceinline__ int a_row(const Unit& u, int r) const { return u.pm * BM + r; }
    __device__ __forceinline__ int b_row(const Unit& u) const { return u.pn * BM; }
};
template <bool GATHER> struct MoeOrder {
    const PG8_LAS int* mt; const PG8_LAS int* hb; const PG8_LAS int* rowtab; int total, G, c;
    __device__ bool next(int i, Unit& u) const {
        int L = i * G + c; if (L >= total) return false;
        int e = 0;
        for (; e < 31; ++e) { const int ue = 4 * mt[e]; if (L < ue) break; L -= ue; }
        const int m = mt[e]; u.e = e; u.pn = L / m; u.pm = L - u.pn * m; u.slot = i; u.hrow0 = hb[e] + 256 * u.pm; return true;
    }
    __device__ __forceinline__ int a_row(const Unit& u, int r) const { if constexpr (GATHER) return rowtab[u.slot * 256 + r]; else return u.hrow0 + r; }
    __device__ __forceinline__ int b_row(const Unit& u) const { return u.e * 1024 + u.pn * BM; }
};

__device__ __forceinline__ unsigned cvt_pk_bf16(float lo, float hi) { unsigned r; asm volatile("v_cvt_pk_bf16_f32 %0, %1, %2" : "=v"(r) : "v"(lo), "v"(hi)); return r; }
__device__ __forceinline__ u32x4 pack8(f32x4 a, f32x4 b) { u32x4 w; w.x = cvt_pk_bf16(a[0], a[1]); w.y = cvt_pk_bf16(a[2], a[3]); w.z = cvt_pk_bf16(b[0], b[1]); w.w = cvt_pk_bf16(b[2], b[3]); return w; }
__device__ __forceinline__ float bflo(unsigned w) { return __uint_as_float(w << 16); }
__device__ __forceinline__ float bfhi(unsigned w) { return __uint_as_float(w & 0xffff0000u); }
__device__ __forceinline__ float gelu_t(float v) { const float u = v * (1.f + 0.044715f * v * v); return v * __builtin_amdgcn_rcpf(1.f + __builtin_amdgcn_exp2f(-2.302208198f * u)); }
__device__ __forceinline__ f32x4 gelu4(f32x4 v) { return (f32x4){gelu_t(v[0]), gelu_t(v[1]), gelu_t(v[2]), gelu_t(v[3])}; }
__device__ __forceinline__ float sigm(float v) { return __builtin_amdgcn_rcpf(1.f + __builtin_amdgcn_exp2f(-LOG2E * v)); }
__device__ __forceinline__ float sq4(f32x4 v) { return (v[0] * v[0] + v[1] * v[1]) + (v[2] * v[2] + v[3] * v[3]); }

struct EpiIn {
    static constexpr bool PERM = true;
    bf16_t* Z; const float* rstd; const float* bias; float* ssv;
    __device__ __forceinline__ void operator()(const f32x4 (&acc)[2][2][4][2], const Unit& u, int wr, int wc, int fr, int fq) const {
        const int row0 = u.pm * BM + wr * 64 + fr, col0 = u.pn * BM + wc * 32 + 8 * fq;
        f32x4 bv[2][2];
#pragma unroll
        for (int bj = 0; bj < 2; ++bj)
#pragma unroll
            for (int n = 0; n < 2; ++n) bv[bj][n] = *(const f32x4*)(bias + col0 + bj * HALF + 4 * n);
        const bool vhalf = u.pn >= 8;
#pragma unroll
        for (int ai = 0; ai < 2; ++ai)
#pragma unroll
            for (int m = 0; m < 4; ++m) { const int row = row0 + ai * HALF + m * 16; const float rs = rstd[row]; float ss = 0.f;
#pragma unroll
                for (int bj = 0; bj < 2; ++bj) { const f32x4 v0 = gelu4(acc[ai][bj][m][0] * rs + bv[bj][0]), v1 = gelu4(acc[ai][bj][m][1] * rs + bv[bj][1]);
                    ss += sq4(v0) + sq4(v1); *(u32x4*)(Z + (size_t)row * ZW + col0 + bj * HALF) = pack8(v0, v1); }
                if (vhalf) { ss += __shfl_xor(ss, 16); ss += __shfl_xor(ss, 32); if (fq == 0) ssv[(size_t)row * 32 + (u.pn - 8) * 4 + wc] = ss; } }
    }
};
struct EpiRes {
    static constexpr bool PERM = true;
    const float* R; float* O; bf16_t* XB;
    __device__ __forceinline__ void operator()(const f32x4 (&acc)[2][2][4][2], const Unit& u, int wr, int wc, int fr, int fq) const {
        const int row0 = u.pm * BM + wr * 64 + fr, col0 = u.pn * BM + wc * 32 + 8 * fq;
#pragma unroll
        for (int ai = 0; ai < 2; ++ai)
#pragma unroll
            for (int m = 0; m < 4; ++m) { const size_t off = (size_t)(row0 + ai * HALF + m * 16) * D + col0;
#pragma unroll
                for (int bj = 0; bj < 2; ++bj) { const f32x4 r0 = *(const f32x4*)(R + off + bj * HALF), r1 = *(const f32x4*)(R + off + bj * HALF + 4);
                    const f32x4 v0 = acc[ai][bj][m][0] + r0, v1 = acc[ai][bj][m][1] + r1;
                    *(f32x4*)(O + off + bj * HALF) = v0; *(f32x4*)(O + off + bj * HALF + 4) = v1; *(u32x4*)(XB + off + bj * HALF) = pack8(v0, v1); } }
    }
};
struct EpiKVQG {
    static constexpr bool PERM = true;
    bf16_t* KB; const float* rstd; const float* kgain; const float* qgain;
    __device__ __forceinline__ void operator()(const f32x4 (&acc)[2][2][4][2], const Unit& u, int wr, int wc, int fr, int fq) const {
        const int sec = u.pn >> 2, head = (u.pn & 3) * 4 + wc, row0 = u.pm * BM + wr * 64 + fr;
        bf16_t* base = KB + (size_t)sec * T * D + head * HD + 8 * fq;
        const bool nrm = (sec == 0) || (sec == 2); const float* g = (sec == 0) ? kgain : qgain; const float post = (sec == 2) ? 0.125f * LOG2E : 1.f;
        f32x4 gv[2][2];
#pragma unroll
        for (int bj = 0; bj < 2; ++bj)
#pragma unroll
            for (int n = 0; n < 2; ++n) gv[bj][n] = *(const f32x4*)(g + 32 * bj + 8 * fq + 4 * n) * post;
#pragma unroll
        for (int ai = 0; ai < 2; ++ai)
#pragma unroll
            for (int m = 0; m < 4; ++m) { const int row = row0 + ai * HALF + m * 16; const float rs = rstd[row];
                f32x4 v[2][2];
#pragma unroll
                for (int bj = 0; bj < 2; ++bj)
#pragma unroll
                    for (int n = 0; n < 2; ++n) v[bj][n] = acc[ai][bj][m][n] * rs;
                if (nrm) { float ss = (sq4(v[0][0]) + sq4(v[0][1])) + (sq4(v[1][0]) + sq4(v[1][1])); ss += __shfl_xor(ss, 16); ss += __shfl_xor(ss, 32);
                    const float r = __builtin_amdgcn_rsqf(ss * (1.f / 64.f) + EPS);
#pragma unroll
                    for (int bj = 0; bj < 2; ++bj)
#pragma unroll
                        for (int n = 0; n < 2; ++n) v[bj][n] = v[bj][n] * r * gv[bj][n]; }
                else if (sec == 3) {
#pragma unroll
                    for (int bj = 0; bj < 2; ++bj)
#pragma unroll
                        for (int n = 0; n < 2; ++n) v[bj][n] = (f32x4){sigm(v[bj][n][0]), sigm(v[bj][n][1]), sigm(v[bj][n][2]), sigm(v[bj][n][3])}; }
#pragma unroll
                for (int bj = 0; bj < 2; ++bj) *(u32x4*)(base + (size_t)row * D + 32 * bj) = pack8(v[bj][0], v[bj][1]); }
    }
};
struct EpiMoe1 {
    static constexpr bool PERM = true;
    bf16_t* HID; const PG8_LAS float* trs;
    __device__ __forceinline__ void operator()(const f32x4 (&acc)[2][2][4][2], const Unit& u, int wr, int wc, int fr, int fq) const {
#pragma unroll
        for (int ai = 0; ai < 2; ++ai)
#pragma unroll
            for (int m = 0; m < 4; ++m) { const int pos = ai * HALF + wr * 64 + m * 16 + fr; const float rs = trs[u.slot * 256 + pos];
                f32x4 hv[2];
#pragma unroll
                for (int n = 0; n < 2; ++n) { const f32x4 a = acc[ai][0][m][n] * rs, b = acc[ai][1][m][n] * rs;
                    hv[n] = (f32x4){a[0] * sigm(a[0]) * b[0], a[1] * sigm(a[1]) * b[1], a[2] * sigm(a[2]) * b[2], a[3] * sigm(a[3]) * b[3]}; }
                *(u32x4*)(HID + (size_t)(u.hrow0 + pos) * DE + u.pn * HALF + wc * 32 + 8 * fq) = pack8(hv[0], hv[1]); }
    }
};
struct EpiMoe2 {
    static constexpr bool PERM = true;
    bf16_t* Y2; const PG8_LAS int* ta; const PG8_LAS float* tw;
    __device__ __forceinline__ void operator()(const f32x4 (&acc)[2][2][4][2], const Unit& u, int wr, int wc, int fr, int fq) const {
        const int col0 = u.pn * BM + wc * 32 + 8 * fq;
#pragma unroll
        for (int ai = 0; ai < 2; ++ai)
#pragma unroll
            for (int m = 0; m < 4; ++m) { const int pos = ai * HALF + wr * 64 + m * 16 + fr; const int a = ta[u.slot * 256 + pos]; const float w = tw[u.slot * 256 + pos];
                if (a >= 0) {
#pragma unroll
                    for (int bj = 0; bj < 2; ++bj) *(u32x4*)(Y2 + (size_t)a * D + col0 + bj * HALF) = pack8(acc[ai][bj][m][0] * w, acc[ai][bj][m][1] * w); } }
    }
};

template <class Epi, class Sched, bool ALIGN_EPI = false, bool SP2 = false>
__device__ __forceinline__ void gemm_phase(PG8_LAS unsigned char* lds, const bf16_t* Aptr, const bf16_t* Btptr, const int K, const Sched& S, const Epi& E) {
    static_assert(SP2, "only the SP2 loop is kept");
    const int tid = threadIdx.x, wid = __builtin_amdgcn_readfirstlane(tid >> 6), lane = tid & 63, wr = wid >> 2, wc = wid & 3, fr = lane & 15, fq = lane >> 4;
    const int nt = K / BK;
    unsigned voffB[2]; int RA[2], CA[2];
#pragma unroll
    for (int i = 0; i < 2; ++i) { int R, C; stage_rc(tid * 16 + i * 8192, R, C); const int Rb = Epi::PERM ? ((R & ~31) + perm32(R & 31)) : R;
        RA[i] = R; CA[i] = C; voffB[i] = (unsigned)(Rb * K + C) * 2u; }
    unsigned vc[2][2], vn[2][2];
#define PG8_AOFF(dst, unit) do { _Pragma("unroll") for (int _h = 0; _h < 2; ++_h) _Pragma("unroll") for (int _i = 0; _i < 2; ++_i) \
        dst[_h][_i] = (unsigned)(S.a_row(unit, _h * HALF + RA[_i]) * K + CA[_i]) * 2u; } while (0)
    const size_t kstep = (size_t)(BK * 2);
    const size_t hstep = (size_t)HALF * K * 2;
    const unsigned ldsw = (unsigned)wid * 1024u;
    const int aoff = lds_byte(wr * 64 + fr, fq * 8), boff = lds_byte(wc * 32 + fr, fq * 8);
#define PG8_SA(b, h) (((b) * 2 + (h)) * HTB)
#define PG8_SB(b, h) ((4 + (b) * 2 + (h)) * HTB)
#define PG8_STAGE(bufoff, gbase, voff) do { _Pragma("unroll") for (int _i = 0; _i < 2; ++_i) \
        __builtin_amdgcn_global_load_lds((const unsigned*)((const char*)(gbase) + (voff)[_i]), (PG8_LAS unsigned*)(lds + (bufoff) + ldsw + _i * 8192), 16, 0, 0); } while (0)
#define PG8_LDA(dst, b, h) do { _Pragma("unroll") for (int m = 0; m < 4; ++m) _Pragma("unroll") for (int k = 0; k < 2; ++k) dst[m][k] = *(const PG8_LAS bf16x8*)(lds + PG8_SA(b, h) + aoff + m * 2048 + k * 1024); } while (0)
#define PG8_LDB(dst, b, h) do { _Pragma("unroll") for (int n = 0; n < 2; ++n) _Pragma("unroll") for (int k = 0; k < 2; ++k) dst[n][k] = *(const PG8_LAS bf16x8*)(lds + PG8_SB(b, h) + boff + n * 2048 + k * 1024); } while (0)
#define PG8_MMA(ai, bj, At, Bt) do { __builtin_amdgcn_s_setprio(1); _Pragma("unroll") for (int m = 0; m < 4; ++m) _Pragma("unroll") for (int n = 0; n < 2; ++n) _Pragma("unroll") for (int k = 0; k < 2; ++k) \
        acc[ai][bj][m][n] = __builtin_amdgcn_mfma_f32_16x16x32_bf16(Bt[n][k], At[m][k], acc[ai][bj][m][n], 0, 0, 0); __builtin_amdgcn_s_setprio(0); } while (0)
#define PG8_WAIT_V(n) asm volatile("s_waitcnt vmcnt(" #n ")" ::: "memory")
#define PG8_WAIT_L(n) asm volatile("s_waitcnt lgkmcnt(" #n ")" ::: "memory")
#define PG8_BAR __builtin_amdgcn_s_barrier()
#define PG8_SCHED __builtin_amdgcn_sched_barrier(0)
    Unit cur, nxt; int ui = 0;
    if (!S.next(0, cur)) return;
    f32x4 acc[2][2][4][2];
#pragma unroll
    for (int a = 0; a < 2; ++a)
#pragma unroll
        for (int b = 0; b < 2; ++b)
#pragma unroll
            for (int m = 0; m < 4; ++m)
#pragma unroll
                for (int n = 0; n < 2; ++n) acc[a][b][m][n] = (f32x4){0.f, 0.f, 0.f, 0.f};
    bf16x8 At[4][2], B0[2][2], B1[2][2];
    const char* const Ab = (const char*)Aptr; const char* cB = (const char*)Btptr + (size_t)S.b_row(cur) * K * 2;
    PG8_AOFF(vc, cur);
    if constexpr (SP2) {
        PG8_STAGE(PG8_SB(0, 0), cB, voffB); PG8_STAGE(PG8_SB(0, 1), cB + hstep, voffB); PG8_STAGE(PG8_SA(0, 0), Ab, vc[0]); PG8_STAGE(PG8_SA(0, 1), Ab, vc[1]);
        if (wr == 1) PG8_BAR;
        PG8_WAIT_V(2); PG8_BAR;
        PG8_STAGE(PG8_SB(1, 0), cB + kstep, voffB); PG8_STAGE(PG8_SA(1, 0), Ab + kstep, vc[0]); PG8_STAGE(PG8_SB(1, 1), cB + hstep + kstep, voffB);
        PG8_WAIT_V(6); PG8_BAR;
    }
    for (;;) {
        const bool has_next = S.next(ui + 1, nxt);
        const char* nB = has_next ? (const char*)Btptr + (size_t)S.b_row(nxt) * K * 2 : cB;
        if (has_next) { PG8_AOFF(vn, nxt); } else { _Pragma("unroll") for (int _h = 0; _h < 2; ++_h) _Pragma("unroll") for (int _i = 0; _i < 2; ++_i) vn[_h][_i] = vc[_h][_i]; }
        for (int t = 0; t < nt; t += 2) {
            const bool last = (t == nt - 2);
            const char* a1 = Ab + (size_t)(t + 1) * kstep;
            const char* a2 = last ? Ab : Ab + (size_t)(t + 2) * kstep; const char* b2 = last ? nB : cB + (size_t)(t + 2) * kstep;
            const char* a3 = a2 + kstep; const char* b3 = b2 + kstep;
            unsigned v2[2][2];
#pragma unroll
            for (int _h = 0; _h < 2; ++_h)
#pragma unroll
                for (int _i = 0; _i < 2; ++_i) v2[_h][_i] = last ? vn[_h][_i] : vc[_h][_i];
            if constexpr (SP2) {
            PG8_LDB(B0, 0, 0); PG8_LDB(B1, 0, 1); PG8_SCHED; PG8_LDA(At, 0, 0); PG8_STAGE(PG8_SA(1, 1), a1, vc[1]);
            PG8_WAIT_V(8); PG8_WAIT_L(0); PG8_BAR; PG8_MMA(0, 0, At, B0); PG8_MMA(0, 1, At, B1); PG8_BAR; PG8_SCHED;
            PG8_LDA(At, 0, 1); PG8_STAGE(PG8_SB(0, 0), b2, voffB); PG8_STAGE(PG8_SB(0, 1), b2 + hstep, voffB); PG8_STAGE(PG8_SA(0, 0), a2, v2[0]);
            PG8_WAIT_V(8); PG8_WAIT_L(0); PG8_BAR; PG8_MMA(1, 0, At, B0); PG8_MMA(1, 1, At, B1); PG8_BAR; PG8_SCHED;
            PG8_LDB(B0, 1, 0); PG8_LDB(B1, 1, 1); PG8_SCHED; PG8_LDA(At, 1, 0); PG8_STAGE(PG8_SA(0, 1), a2, v2[1]);
            PG8_WAIT_V(8); PG8_WAIT_L(0); PG8_BAR; PG8_MMA(0, 0, At, B0); PG8_MMA(0, 1, At, B1); PG8_BAR; PG8_SCHED;
            PG8_LDA(At, 1, 1); PG8_STAGE(PG8_SB(1, 0), b3, voffB); PG8_STAGE(PG8_SB(1, 1), b3 + hstep, voffB); PG8_STAGE(PG8_SA(1, 0), a3, v2[0]);
            PG8_WAIT_V(8); PG8_WAIT_L(0); PG8_BAR; PG8_MMA(1, 0, At, B0); PG8_MMA(1, 1, At, B1); PG8_BAR; PG8_SCHED;
            }
        }
        if constexpr (ALIGN_EPI) { if (wr == 0) PG8_BAR; }
        E(acc, cur, wr, wc, fr, fq);
        if (!has_next) break;
#pragma unroll
        for (int a = 0; a < 2; ++a)
#pragma unroll
            for (int b = 0; b < 2; ++b)
#pragma unroll
                for (int m = 0; m < 4; ++m)
#pragma unroll
                    for (int n = 0; n < 2; ++n) acc[a][b][m][n] = (f32x4){0.f, 0.f, 0.f, 0.f};
        cur = nxt; cB = nB; ++ui;
#pragma unroll
        for (int _h = 0; _h < 2; ++_h)
#pragma unroll
            for (int _i = 0; _i < 2; ++_i) vc[_h][_i] = vn[_h][_i];
        if constexpr (ALIGN_EPI) { if (wr == 1) PG8_BAR; }
    }
    PG8_WAIT_V(0);
    if constexpr (!ALIGN_EPI) { if (wr == 0) PG8_BAR; }
    PG8_BAR;
#undef PG8_AOFF
#undef PG8_SA
#undef PG8_SB
#undef PG8_STAGE
#undef PG8_LDA
#undef PG8_LDB
#undef PG8_MMA
#undef PG8_WAIT_V
#undef PG8_WAIT_L
#undef PG8_BAR
#undef PG8_SCHED
}
}


namespace attn_body {
using bf16=__hip_bfloat16;
using bf16x8=__attribute__((ext_vector_type(8)))short;
using s16x4=__attribute__((ext_vector_type(4)))short;
using f32x16=__attribute__((ext_vector_type(16)))float;
using u32x4=__attribute__((ext_vector_type(4)))unsigned;
using f32x4v=__attribute__((ext_vector_type(4)))float;
constexpr int BATCH=4,NHEAD=16,SEQ=4096,D=64,DM=NHEAD*D;
constexpr int NW=8,QBLK=32,QB=QBLK*NW,KVBLK=64,NQB=SEQ/QB;
constexpr int ATTN_PITCH=DM, ATTN_UNIT_ROWS=QB;
__device__ __forceinline__ int crow(int r,int hi){return (r&3)+8*(r>>2)+4*hi;}
#define SBAR() __builtin_amdgcn_sched_barrier(0)
__device__ __forceinline__ void cmask(f32x16&p0,f32x16&p1,int jb,int qrel,int hi){
  const float NEG=-INFINITY; int kb=64*jb+4*hi;
  #pragma unroll
  for(int r=0;r<16;++r){int kv=kb+(r&3)+8*(r>>2); if(kv>qrel)p0[r]=NEG; if(kv+32>qrel)p1[r]=NEG;}
}

constexpr int NSLOT=3, SLOTB=8192;
constexpr int LDS_K=0, LDS_V=NSLOT*SLOTB, LDS_WS=2*NSLOT*SLOTB, LDS_OST=LDS_WS+NW*64*4, LDS_CK=LDS_OST+NW*4096, LDS_BYTES=LDS_CK+SEQ*4;
constexpr float C2=0.125f*1.4426950408889634f;
__device__ __forceinline__ void glds16(const void*gsrc,unsigned lds_dst){unsigned keep;
  asm volatile("s_mov_b32 %0, m0\n\ts_mov_b32 m0, %2\n\ts_nop 0\n\tglobal_load_lds_dwordx4 %1, off\n\ts_mov_b32 m0, %0":"=&s"(keep):"v"(gsrc),"s"(lds_dst):"memory");}
__device__ __forceinline__ float max3f(float a,float b,float c){float r;asm("v_max3_f32 %0, %1, %2, %3":"=v"(r):"v"(a),"v"(b),"v"(c));return r;}
__device__ __forceinline__ float max2f(float a,float b){float r;asm("v_max_f32_e32 %0, %1, %2":"=v"(r):"v"(a),"v"(b));return r;}
__device__ __forceinline__ float fadd_s(float a,float b){float r;asm("v_add_f32_e32 %0, %1, %2":"=v"(r):"v"(a),"v"(b));return r;}
__device__ __forceinline__ float fsub_s(float a,float b){float r;asm("v_sub_f32_e32 %0, %1, %2":"=v"(r):"v"(a),"v"(b));return r;}
typedef float f32x2_t __attribute__((ext_vector_type(2))); typedef __bf16 bf16x2_t __attribute__((ext_vector_type(2)));
__device__ __forceinline__ unsigned cvtpk_s(float lo,float hi){f32x2_t v={lo,hi};bf16x2_t b=__builtin_convertvector(v,bf16x2_t);return __builtin_bit_cast(unsigned,b);}
#define WAIT_BAR(N) asm volatile("s_waitcnt vmcnt(" #N ") lgkmcnt(0)\n\ts_barrier":::"memory")

__device__ __forceinline__ void qkt(f32x16&p0,f32x16&p1,const char*Kslot,const bf16x8*qr,int r32,int hi){
  const char*kb=Kslot+hi*1024+r32*16;
  #pragma unroll
  for(int d0=0;d0<4;++d0){
    const bf16x8 b0=*reinterpret_cast<const bf16x8*>(kb+d0*2048);
    const bf16x8 b1=*reinterpret_cast<const bf16x8*>(kb+d0*2048+512);
    p0=__builtin_amdgcn_mfma_f32_32x32x16_bf16(b0,qr[d0],p0,0,0,0);p1=__builtin_amdgcn_mfma_f32_32x32x16_bf16(b1,qr[d0],p1,0,0,0);}
}
typedef __attribute__((address_space(3))) const char* lds_cptr;
typedef short v4i16_t __attribute__((ext_vector_type(4)));
__device__ __forceinline__ void kload8(bf16x8*kf,lds_cptr kp){
  kf[0]=*(const __attribute__((address_space(3))) bf16x8*)(kp);      kf[1]=*(const __attribute__((address_space(3))) bf16x8*)(kp+512);
  kf[2]=*(const __attribute__((address_space(3))) bf16x8*)(kp+2048); kf[3]=*(const __attribute__((address_space(3))) bf16x8*)(kp+2560);
  kf[4]=*(const __attribute__((address_space(3))) bf16x8*)(kp+4096); kf[5]=*(const __attribute__((address_space(3))) bf16x8*)(kp+4608);
  kf[6]=*(const __attribute__((address_space(3))) bf16x8*)(kp+6144); kf[7]=*(const __attribute__((address_space(3))) bf16x8*)(kp+6656);
}
__device__ __forceinline__ void kload2(bf16x8*kf,lds_cptr kp,int j){ kf[2*j]=*(const __attribute__((address_space(3))) bf16x8*)(kp+j*2048); kf[2*j+1]=*(const __attribute__((address_space(3))) bf16x8*)(kp+j*2048+512); }
__device__ __forceinline__ s16x4 vtr(lds_cptr p){ return __builtin_bit_cast(s16x4,__builtin_amdgcn_ds_read_tr16_b64_v4i16((__attribute__((address_space(3))) v4i16_t*)p)); }
__device__ __forceinline__ float rowmax(const f32x16&p0,const f32x16&p1){
  float a=max3f(p0[0],p0[1],p1[0]),b=max3f(p0[2],p0[3],p1[1]);a=max3f(a,p1[2],p1[3]);
  #pragma unroll
  for(int r=4;r<16;r+=4){a=max3f(a,p0[r],p0[r+1]);b=max3f(b,p0[r+2],p0[r+3]);a=max3f(a,p1[r],p1[r+1]);b=max3f(b,p1[r+2],p1[r+3]);}
  const float m=max2f(a,b);
  auto rr=__builtin_amdgcn_permlane32_swap(__float_as_uint(m),__float_as_uint(m),false,false);
  return max2f(__uint_as_float(rr[0]),__uint_as_float(rr[1]));
}
__device__ __forceinline__ void pv(f32x16*o,int vb,bf16x8 pa0,bf16x8 pa1,bf16x8 pa2,bf16x8 pa3){
  #pragma unroll
  for(int d0=0;d0<2;++d0){s16x4 lo[4],hi[4];
    #pragma unroll
    for(int ks=0;ks<4;++ks){
      asm volatile("ds_read_b64_tr_b16 %0,%1 offset:%c2":"=&v"(lo[ks]):"v"(vb),"i"(d0*4096+ks*1024):"memory");
      asm volatile("ds_read_b64_tr_b16 %0,%1 offset:%c2":"=&v"(hi[ks]):"v"(vb),"i"(d0*4096+ks*1024+512):"memory");}
    asm volatile("s_waitcnt lgkmcnt(0)":::"memory");SBAR();
    #define PK(k) (bf16x8){lo[k][0],lo[k][1],lo[k][2],lo[k][3],hi[k][0],hi[k][1],hi[k][2],hi[k][3]}
    o[d0]=__builtin_amdgcn_mfma_f32_32x32x16_bf16(pa0,PK(0),o[d0],0,0,0);
    o[d0]=__builtin_amdgcn_mfma_f32_32x32x16_bf16(pa1,PK(1),o[d0],0,0,0);
    o[d0]=__builtin_amdgcn_mfma_f32_32x32x16_bf16(pa2,PK(2),o[d0],0,0,0);
    o[d0]=__builtin_amdgcn_mfma_f32_32x32x16_bf16(pa3,PK(3),o[d0],0,0,0);
    #undef PK
  }
}

#ifndef ATTN_STORE16
#define ATTN_STORE16(p,v) (*(u32x4*)(p)=(v))
#endif
template<int THRL> __device__ __forceinline__ void attn_unit(int b,int h,int qb,const bf16*Q,const bf16*__restrict__ K,const bf16*__restrict__ V,const bf16*__restrict__ Gt,const float*__restrict__ cum,float TH,bf16*O,char*shm){
  const int tid=threadIdx.x,lane=tid&63,r32=lane&31,hi=lane>>5; const int wid=__builtin_amdgcn_readfirstlane(tid>>6);
  const long rowbase=(long)b*SEQ; const int q0=qb*QB;
  const bf16*Qw=Q+(rowbase+q0+wid*QBLK)*DM+h*D;
  const float*cb=cum+(long)(b*NHEAD+h)*SEQ; const int NTF=(q0+QB)/KVBLK;
  int tstart;
  { const float cq0=cb[q0]; const float ce=cb[(lane<NTF?lane:NTF-1)*KVBLK+KVBLK-1];
    __attribute__((address_space(3))) float*ckw=(__attribute__((address_space(3))) float*)((__attribute__((address_space(3))) char*)shm+LDS_CK);
    #pragma unroll
    for(int j=0;j<2;++j){ const int idx=tid*4+j*2048; if(idx<q0+QB){ const f32x4v v=*reinterpret_cast<const f32x4v*>(cb+idx); const f32x4v w=(cq0-v)*1.4426950408889634f; *(__attribute__((address_space(3))) f32x4v*)(ckw+idx)=w; } }
    const unsigned long long need=__ballot((lane<NTF)&&(ce-cq0<=TH));
    int fs=need?(int)__builtin_ctzll(need):0; if(fs>NTF-4)fs=NTF-4; tstart=__builtin_amdgcn_readfirstlane(fs&~1); }
  const bf16*Kh=K+(rowbase+(long)tstart*KVBLK)*DM+h*D,*Vh=V+(rowbase+(long)tstart*KVBLK)*DM+h*D;
  const __attribute__((address_space(3))) f32x4v* ckp=(const __attribute__((address_space(3))) f32x4v*)((lds_cptr)shm+LDS_CK)+tstart*16+hi;
  const unsigned lds0=(unsigned)(uintptr_t)shm;
  float*wsf=(float*)(shm+LDS_WS)+wid*64;
  const bf16*ksrc=Kh+(long)lane*DM+wid*8;
  const bf16*vsrc=Vh+(long)(16*(wid&3)+(lane>>2))*DM+(wid>>2)*32+(lane&3)*8;
  const unsigned kdst=lds0+LDS_K+wid*1024, vdst=lds0+LDS_V+wid*1024;
  #define DMA_K(t,slot) glds16(ksrc+(long)(t)*KVBLK*DM,(unsigned)__builtin_amdgcn_readfirstlane(kdst+(slot)))
  #define DMA_V(t,slot) glds16(vsrc+(long)(t)*KVBLK*DM,(unsigned)__builtin_amdgcn_readfirstlane(vdst+(slot)))
  const int vb0=(int)(lds0+LDS_V)+((lane>>4)&1)*32+(lane&3)*8+(4*hi+((lane&15)>>2))*64;
  const char*Kbase=shm+LDS_K; bf16x8 kf[8];
  const lds_cptr shm3=(lds_cptr)shm; const lds_cptr kp0=shm3+LDS_K+hi*1024+r32*16; const lds_cptr vp0=shm3+LDS_V+((lane>>4)&1)*32+(lane&3)*8+(4*hi+((lane&15)>>2))*64;
  const int NT=NTF-tstart;
  DMA_K(0,0);DMA_V(0,0);DMA_K(1,SLOTB);
  bf16x8 qr[4];
  #pragma unroll
  for(int d0=0;d0<4;++d0)qr[d0]=*reinterpret_cast<const bf16x8*>(&Qw[(long)r32*DM+d0*16+hi*8]);
  float mhat=0.f,l_reg=0.f;f32x16 o[2];o[0]=f32x16{};o[1]=f32x16{};
  #define CINIT(C0,C1,t) do{ const __attribute__((address_space(3))) f32x4v* cp_=ckp+(t)*16; _Pragma("unroll") for(int g_=0;g_<4;++g_){ const f32x4v b0_=cp_[2*g_],b1_=cp_[2*g_+8]; \
      _Pragma("unroll") for(int i_=0;i_<4;++i_){C0[4*g_+i_]=b0_[i_]-mhat;C1[4*g_+i_]=b1_[i_]-mhat;} } }while(0)
  const int qrel=wid*QBLK+r32;
  #define CMASK(P0,P1,t) do{int jb_=(t)-(NT-4); if(jb_>=0)cmask(P0,P1,jb_,qrel,hi);}while(0)
  bool resc=false;
  #define START(P0,P1) do{ const float rm=rowmax(P0,P1); resc=false; \
    { const float dl=rm; mhat=fadd_s(mhat,dl); \
      _Pragma("unroll") for(int r=0;r<16;++r){P0[r]=fsub_s(P0[r],dl);P1[r]=fsub_s(P1[r],dl);} } \
    _Pragma("unroll") for(int r=0;r<16;++r)P0[r]=__builtin_amdgcn_exp2f(P0[r]); }while(0)
  #define RESC() do{ if(resc){ asm volatile("s_waitcnt lgkmcnt(0)":::"memory"); \
      _Pragma("unroll") for(int d_=0;d_<2;++d_) _Pragma("unroll") for(int r=0;r<16;++r)o[d_][r]*=wsf[crow(r,hi)]; } }while(0)
  f32x16 pA0,pA1,pB0,pB1;
  int sl_prev=0,sl_cur=0,sl_next=SLOTB;
  #define ROT() do{sl_prev=sl_cur;sl_cur=sl_next;sl_next=(sl_next==(NSLOT-1)*SLOTB)?0:sl_next+SLOTB;}while(0)
  DMA_K(2,2*SLOTB);
  WAIT_BAR(3);
  CINIT(pA0,pA1,0); qkt(pA0,pA1,Kbase,qr,r32,hi);asm volatile("s_nop 15\n\ts_nop 7":"+v"(pA0),"+v"(pA1));CMASK(pA0,pA1,0);
  START(pA0,pA1);
  _Pragma("unroll") for(int r=0;r<16;++r)pA1[r]=__builtin_amdgcn_exp2f(pA1[r]);
  WAIT_BAR(0);
  DMA_K(3,0);DMA_V(1,SLOTB);
  ROT();
  kload8(kf,kp0+sl_cur);
  WAIT_BAR(2);
  s16x4 vlo[8],vhi[8]; u32x4 pw0,pw1,pw2,pw3;
  #define PKW(P,B) cvtpk_s(P[B],P[B+1])
  #define PAF(k) __builtin_bit_cast(bf16x8,pw##k)
  #define VFR(i) (bf16x8){vlo[i][0],vlo[i][1],vlo[i][2],vlo[i][3],vhi[i][0],vhi[i][1],vhi[i][2],vhi[i][3]}
  #define PIN(x) asm volatile("":"+v"(x))
  #define MX3(a,b,c) __builtin_fmaxf(__builtin_fmaxf((a),(b)),(c))
  #define GAPA(MF,A0,A1,A2,A3,W0,W1,PW) do{ MF; sacc+=A0; sacc+=A1; sacc+=A2; sacc+=A3; PIN(sacc); W0; W1; PIN(PW); SBAR(); }while(0)
  #define EX(v) __builtin_amdgcn_exp2f(v)
  #define GAPB(MF,X,B) do{ MF; X[B]=EX(X[B]); X[B+1]=EX(X[B+1]); X[B+2]=EX(X[B+2]); X[B+3]=EX(X[B+3]); PIN(X); SBAR(); }while(0)
  #define VRD(i) do{ vlo[i]=vtr(vp_+(((i)>>2)*4096+((i)&3)*1024)); vhi[i]=vtr(vp_+(((i)>>2)*4096+((i)&3)*1024+512)); }while(0)
  #define KRD(G,j) do{ if(G){ kload2(kf,kp0+sl_next,j); SBAR(); } }while(0)
  #define STEP(C0,C1,P0,P1,t,GK,GV,GL) do{ SBAR(); CINIT(C0,C1,t); SBAR(); \
    const lds_cptr vp_=vp0+sl_prev; \
    VRD(0); SBAR(); float sacc=(P0[0]+P0[1]); \
    GAPA(C0=__builtin_amdgcn_mfma_f32_32x32x16_bf16(kf[0],qr[0],C0,0,0,0), P0[2],P0[3],P0[4],P0[5],     pw0[0]=PKW(P0,0), pw0[1]=PKW(P0,2), pw0); \
    VRD(4); SBAR(); GAPA(C1=__builtin_amdgcn_mfma_f32_32x32x16_bf16(kf[1],qr[0],C1,0,0,0), P0[6],P0[7],P0[8],P0[9],     pw0[2]=PKW(P0,4), pw0[3]=PKW(P0,6), pw0); \
    VRD(1); SBAR(); GAPA(C0=__builtin_amdgcn_mfma_f32_32x32x16_bf16(kf[2],qr[1],C0,0,0,0),   P0[10],P0[11],P0[12],P0[13], pw1[0]=PKW(P0,8), pw1[1]=PKW(P0,10), pw1); \
    VRD(5); SBAR(); GAPA(C1=__builtin_amdgcn_mfma_f32_32x32x16_bf16(kf[3],qr[1],C1,0,0,0),   P0[14],P0[15],P1[0],P1[1],   pw1[2]=PKW(P0,12),pw1[3]=PKW(P0,14), pw1); \
    VRD(2); SBAR(); GAPA(C0=__builtin_amdgcn_mfma_f32_32x32x16_bf16(kf[4],qr[2],C0,0,0,0),   P1[2],P1[3],P1[4],P1[5],     pw2[0]=PKW(P1,0), pw2[1]=PKW(P1,2), pw2); \
    VRD(6); SBAR(); GAPA(C1=__builtin_amdgcn_mfma_f32_32x32x16_bf16(kf[5],qr[2],C1,0,0,0),   P1[6],P1[7],P1[8],P1[9],     pw2[2]=PKW(P1,4), pw2[3]=PKW(P1,6), pw2); \
    VRD(3); SBAR(); GAPA(C0=__builtin_amdgcn_mfma_f32_32x32x16_bf16(kf[6],qr[3],C0,0,0,0),   P1[10],P1[11],P1[12],P1[13], pw3[0]=PKW(P1,8), pw3[1]=PKW(P1,10), pw3); \
    VRD(7); SBAR(); GAPA(C1=__builtin_amdgcn_mfma_f32_32x32x16_bf16(kf[7],qr[3],C1,0,0,0),   P1[14],P1[15],0.f,0.f,       pw3[2]=PKW(P1,12),pw3[3]=PKW(P1,14), pw3); \
    l_reg+=sacc; \
    if(GK){DMA_K((t)+3,sl_cur);} if(GV){DMA_V((t)+1,sl_next);} \
    CMASK(C0,C1,t); \
    { float a=MX3(C0[0],C0[1],C1[0]),b=MX3(C0[2],C0[3],C1[1]); a=MX3(a,C1[2],C1[3]); \
      _Pragma("unroll") for(int r=4;r<16;r+=4){a=MX3(a,C0[r],C0[r+1]);b=MX3(b,C0[r+2],C0[r+3]);a=MX3(a,C1[r],C1[r+1]);b=MX3(b,C1[r+2],C1[r+3]);} \
      float rm=__builtin_fmaxf(a,b); { auto rr=__builtin_amdgcn_permlane32_swap(__float_as_uint(rm),__float_as_uint(rm),false,false); rm=__builtin_fmaxf(__uint_as_float(rr[0]),__uint_as_float(rr[1])); } \
      resc=false; \
      if(__builtin_expect(__any(rm>(float)THRL),0)){ const float dl=__builtin_fmaxf(rm,0.f); mhat+=dl; \
        _Pragma("unroll") for(int r=0;r<16;++r){C0[r]-=dl;C1[r]-=dl;} \
        const float f=__builtin_amdgcn_exp2f(-dl); l_reg*=f; if(hi==0)wsf[r32]=f; resc=true; } } \
    SBAR(); \
    GAPB(o[0]=__builtin_amdgcn_mfma_f32_32x32x16_bf16(PAF(0),VFR(0),o[0],0,0,0), C0,0); \
    GAPB(o[1]=__builtin_amdgcn_mfma_f32_32x32x16_bf16(PAF(0),VFR(4),o[1],0,0,0), C0,4); \
    KRD(GL,0); GAPB(o[0]=__builtin_amdgcn_mfma_f32_32x32x16_bf16(PAF(1),VFR(1),o[0],0,0,0), C0,8); \
    KRD(GL,1); GAPB(o[1]=__builtin_amdgcn_mfma_f32_32x32x16_bf16(PAF(1),VFR(5),o[1],0,0,0), C0,12); \
    KRD(GL,2); GAPB(o[0]=__builtin_amdgcn_mfma_f32_32x32x16_bf16(PAF(2),VFR(2),o[0],0,0,0), C1,0); \
    KRD(GL,3); GAPB(o[1]=__builtin_amdgcn_mfma_f32_32x32x16_bf16(PAF(2),VFR(6),o[1],0,0,0), C1,4); \
    GAPB(o[0]=__builtin_amdgcn_mfma_f32_32x32x16_bf16(PAF(3),VFR(3),o[0],0,0,0), C1,8); \
    GAPB(o[1]=__builtin_amdgcn_mfma_f32_32x32x16_bf16(PAF(3),VFR(7),o[1],0,0,0), C1,12); \
    }while(0)
  int t=1;
  #undef CMASK
  #define CMASK(P0,P1,t) do{}while(0)
  for(;t+5<NT;t+=2){
    STEP(pB0,pB1,pA0,pA1,t,true,true,true);     WAIT_BAR(2); RESC(); ROT();
    STEP(pA0,pA1,pB0,pB1,t+1,true,true,true);   WAIT_BAR(2); RESC(); ROT();
  }
  #undef CMASK
  #define CMASK(P0,P1,t) do{int jb_=(t)-(NT-4); if(jb_>=0)cmask(P0,P1,jb_,qrel,hi);}while(0)
  #define ENDW(tt) do{ if((tt)+3<NT){WAIT_BAR(2);} else if((tt)+2<NT){WAIT_BAR(1);} else {WAIT_BAR(0);} }while(0)
  for(;t+1<NT;t+=2){
    STEP(pB0,pB1,pA0,pA1,t,(t+3<NT),(t+1<NT),(t+1<NT));       ENDW(t);   RESC(); ROT();
    STEP(pA0,pA1,pB0,pB1,t+1,(t+4<NT),(t+2<NT),(t+2<NT));     ENDW(t+1); RESC(); ROT();
  }
  STEP(pB0,pB1,pA0,pA1,NT-1,false,false,false); RESC();
  { float sacc=pB0[0]+pB0[1]; _Pragma("unroll") for(int r=2;r<16;++r)sacc+=pB0[r]; _Pragma("unroll") for(int r=0;r<16;++r)sacc+=pB1[r]; l_reg+=sacc;
    pw0=(u32x4){PKW(pB0,0),PKW(pB0,2),PKW(pB0,4),PKW(pB0,6)};pw1=(u32x4){PKW(pB0,8),PKW(pB0,10),PKW(pB0,12),PKW(pB0,14)};pw2=(u32x4){PKW(pB1,0),PKW(pB1,2),PKW(pB1,4),PKW(pB1,6)};pw3=(u32x4){PKW(pB1,8),PKW(pB1,10),PKW(pB1,12),PKW(pB1,14)};
    SBAR(); pv(o,vb0+sl_cur,PAF(0),PAF(1),PAF(2),PAF(3)); }
  #undef PKW
  #undef PAF
  #undef VFR
  #undef PIN
  #undef MX3
  #undef GAPA
  #undef GAPB
  #undef EX
  #undef VRD
  #undef KRD
  #undef STEP
  #undef ENDW
  {auto rr=__builtin_amdgcn_permlane32_swap(__float_as_uint(l_reg),__float_as_uint(l_reg),false,false);l_reg=__uint_as_float(rr[0])+__uint_as_float(rr[1]);}
  if(hi==0)wsf[32+r32]=l_reg;asm volatile("s_waitcnt lgkmcnt(0)":::"memory");
  float rli[16];
  #pragma unroll
  for(int r=0;r<16;++r)rli[r]=__builtin_amdgcn_rcpf(wsf[32+crow(r,hi)]);
  bf16*Ow=O+(rowbase+q0+wid*QBLK)*DM+h*D;
  { bf16*stg=(bf16*)(shm+LDS_OST)+wid*2048;
    #pragma unroll
    for(int r=0;r<16;++r){const int orow=crow(r,hi);
      #pragma unroll
      for(int d0=0;d0<2;++d0)stg[orow*64+d0*32+r32]=__float2bfloat16(o[d0][r]*rli[r]);}
    asm volatile("s_waitcnt lgkmcnt(0)":::"memory");
    const bf16*Gw=Gt+(rowbase+q0+wid*QBLK)*DM+h*D;
    #pragma unroll
    for(int i=0;i<4;++i){const int row=i*8+(lane>>3),ch=lane&7; u32x4 v=*(const u32x4*)(stg+row*64+ch*8); const u32x4 gg=*(const u32x4*)(Gw+(long)row*DM+ch*8);
      #pragma unroll
      for(int e_=0;e_<4;++e_){ const float lo=__uint_as_float(v[e_]<<16)*__uint_as_float(gg[e_]<<16), hi_=__uint_as_float(v[e_]&0xffff0000u)*__uint_as_float(gg[e_]&0xffff0000u); v[e_]=cvtpk_s(lo,hi_); }
      ATTN_STORE16(Ow+(long)row*DM+ch*8,v);} }
  asm volatile("s_waitcnt lgkmcnt(0)\n\ts_barrier":::"memory");
  #undef CINIT
  #undef DMA_K
  #undef DMA_V
  #undef CMASK
  #undef START
  #undef RESC
  #undef ROT
}
constexpr int ATTN_LDS_BYTES=LDS_BYTES;
struct AttnTensors { const bf16* Q; const bf16* K; const bf16* V; const bf16* G; const float* cum; float TH; bf16* O; };
struct AttnUnit { int bh; int qb; };
struct StaticOrder {
  int vcu, grid;
  __device__ __forceinline__ explicit StaticOrder(int grid_,int block):vcu((grid_%8==0)?(block%8)*(grid_/8)+block/8:block),grid(grid_){}
  __device__ __forceinline__ bool next(int i,AttnUnit&u)const{
    if(grid==256){ if(i>=4)return false; const int s=vcu&3; u.bh=vcu>>2; u.qb=(i==0)?s:(i==1)?7-s:(i==2)?8+s:15-s; return true; }
    const int L=i*grid+vcu; if(L>=BATCH*NHEAD*NQB)return false; u.bh=L/NQB; u.qb=L%NQB; return true; }
};
template<class Sched,int THRL=8> __device__ __forceinline__ void attn_phase(char*lds,const AttnTensors&T,const Sched&S){
  AttnUnit u;
  for(int i=0;S.next(i,u);++i){ attn_unit<THRL>(u.bh/NHEAD,u.bh%NHEAD,u.qb,T.Q,T.K,T.V,T.G,T.cum,T.TH,T.O,lds); }
}
#undef SBAR
#undef WAIT_BAR
}

constexpr size_t MiB = 1u << 20;
constexpr size_t WS_CTL = 0, CTL_ZERO_BYTES = 1 * MiB;
constexpr size_t WS_RSTD = 1 * MiB;
constexpr size_t WS_SSV = 2 * MiB;
constexpr size_t WS_LF = 4 * MiB, WS_CUM = 5 * MiB;
constexpr size_t WS_LA = 6 * MiB, WS_LW = 8 * MiB, WS_LR = 10 * MiB;
constexpr size_t WS_WRT = 12 * MiB;
constexpr size_t WS_WFT = 12 * MiB + 512 * 1024;
constexpr size_t WS_WSM = 13 * MiB;
constexpr size_t WS_WIN = 16 * MiB, WS_WOUT = 24 * MiB, WS_WKVQG = 28 * MiB, WS_WO = 36 * MiB;
constexpr size_t WS_W13 = 40 * MiB, WS_W2 = 104 * MiB;
constexpr size_t WS_XB = 136 * MiB;
constexpr size_t WS_BIG = 168 * MiB;
constexpr size_t WS_GY = 296 * MiB;
constexpr size_t WS_HID = 360 * MiB;
constexpr size_t WS_END = 400 * MiB;
static_assert(WS_HID + (size_t)HID_ROWS * DE * 2 <= WS_END, "ws map");
constexpr int CW_TMO = 0, CW_CODE = 1, CW_BAR = 4096, CW_CNT = 8192;

constexpr int RING_OFF = 0, RING_BYTES = 131072;
constexpr int LDSCTL_OFF = RING_BYTES, MISC_OFF = LDSCTL_OFF + 320;
constexpr int TAB_OFF = LDSCTL_OFF + 512;
constexpr int TABA_OFF = TAB_OFF + 512, TABF_OFF = TABA_OFF + 3072;
constexpr int LDS_BYTES = 147456;
static_assert(TABF_OFF + 3072 <= LDS_BYTES, "LDS map");
constexpr int NWAVES = 8;
constexpr int NPH = 15;

typedef unsigned short bf16;
typedef unsigned v4u __attribute__((ext_vector_type(4)));
typedef unsigned v2u __attribute__((ext_vector_type(2)));
typedef float f32x4 __attribute__((ext_vector_type(4)));
typedef short bf16x8 __attribute__((ext_vector_type(8)));
typedef GAS unsigned gu32;
#define RLX_AGENT __ATOMIC_RELAXED, __HIP_MEMORY_SCOPE_AGENT
#define LDS_WAIT() asm volatile("s_waitcnt lgkmcnt(0)" ::: "memory")
#define VM_WAIT() asm volatile("s_waitcnt vmcnt(0)" ::: "memory")
__device__ __forceinline__ unsigned pk2(float lo, float hi) { return pg8::cvt_pk_bf16(lo, hi); }
__device__ __forceinline__ float bf_lo(unsigned w) { return __uint_as_float(w << 16); }
__device__ __forceinline__ float bf_hi(unsigned w) { return __uint_as_float(w & 0xffff0000u); }

#define XB_TMO      128
#define XB_XCNT(j)  (256  + 64 * (j))
#define XB_XSUB(j)  (1280 + 64 * (j))
#define XB_XGEN(j)  (2304 + 64 * (j))
#define XB_TOP      3328
#define XB_TOPGEN   3392
#define XCD_BAR_WORDS 3456
#define XB_SPIN_CAP (1u << 18)

__device__ __forceinline__ unsigned xb_ld(unsigned* p)              { return __hip_atomic_load(p, __ATOMIC_RELAXED, __HIP_MEMORY_SCOPE_AGENT); }
__device__ __forceinline__ unsigned xb_add(unsigned* p, unsigned v) { return __hip_atomic_fetch_add(p, v, __ATOMIC_RELAXED, __HIP_MEMORY_SCOPE_AGENT); }
__device__ __forceinline__ unsigned xb_xcc_id() { return (unsigned)__builtin_amdgcn_s_getreg((3 << 11) | 20) & 0xFu; }
#define XB_SPIN(cond, bar) do { unsigned _sp = 0; while (cond) { __builtin_amdgcn_s_sleep(1); \
    if ((++_sp & 255u) == 0u) { if (xb_ld(&(bar)[XB_TMO])) break; if (_sp > XB_SPIN_CAP) { atomicAdd(&(bar)[XB_TMO], 1u); break; } } } } while (0)

struct XcdBarrier {
    unsigned* bar; unsigned x;
    volatile LAS unsigned* st;
};

__device__ __forceinline__ XcdBarrier xcd_barrier_post(unsigned* bar, volatile LAS unsigned* st) {
    XcdBarrier b; b.bar = bar; b.x = xb_xcc_id(); b.st = st;
    if (threadIdx.x == 0) (void)xb_add(&bar[XB_XCNT(b.x)], 1u);
    return b;
}
__device__ __forceinline__ void xcd_barrier_complete(unsigned* bar, unsigned x, unsigned& nloc, unsigned& nx) {
    const unsigned G = gridDim.x * gridDim.y * gridDim.z;
    unsigned sum, cnt, mine, sp = 0u;
    for (;;) {
        sum = 0u; cnt = 0u; mine = 0u;
#pragma unroll
        for (unsigned j = 0; j < 16; ++j) { const unsigned c = xb_ld(&bar[XB_XCNT(j)]); sum += c; cnt += (c > 0u) ? 1u : 0u; mine = (j == x) ? c : mine; }
        if (sum == G) break;
        __builtin_amdgcn_s_sleep(1);
        if ((++sp & 255u) == 0u) { if (xb_ld(&bar[XB_TMO])) break; if (sp > XB_SPIN_CAP) { atomicAdd(&bar[XB_TMO], 1u); break; } }
    }
    nloc = mine > 0u ? mine : 1u; nx = cnt > 0u ? cnt : 1u;
}

__device__ __forceinline__ void xcd_barrier(const XcdBarrier& b) {
    asm volatile("s_waitcnt vmcnt(0)" ::: "memory");
    __syncthreads();
    if (threadIdx.x == 0) {
        unsigned* bar = b.bar;
        __builtin_amdgcn_s_waitcnt(0);
        unsigned nloc = b.st[0], nx = b.st[1];
        if (nloc == 0u) { xcd_barrier_complete(bar, b.x, nloc, nx); b.st[0] = nloc; b.st[1] = nx; }
        const unsigned old = xb_add(&bar[XB_XSUB(b.x)], 1u);
        const unsigned gen = old / nloc;
        if (old + 1u == (gen + 1u) * nloc) {
            __builtin_amdgcn_fence(__ATOMIC_RELEASE, "agent");
            asm volatile("s_waitcnt vmcnt(0)" ::: "memory");
            const unsigned og = xb_add(&bar[XB_TOP], 1u);
            const unsigned tg = og / nx;
            if (og + 1u == (tg + 1u) * nx) xb_add(&bar[XB_TOPGEN], 1u);
            else XB_SPIN(xb_ld(&bar[XB_TOPGEN]) == tg, bar);
            __builtin_amdgcn_fence(__ATOMIC_ACQUIRE, "agent");
            xb_add(&bar[XB_XGEN(b.x)], 1u);
            asm volatile("s_waitcnt vmcnt(0)" ::: "memory");
        } else {
            XB_SPIN(xb_ld(&bar[XB_XGEN(b.x)]) == gen, bar);
            __builtin_amdgcn_fence(__ATOMIC_ACQUIRE, "agent");
            asm volatile("s_waitcnt vmcnt(0)" ::: "memory");
        }
    }
    __syncthreads();
}

struct Frame {
    LAS unsigned char* lds;
    volatile LAS unsigned* MISC;
    gu32* ctl;
    int tid, lane, wave, vcu, G;
    const float* in[24]; float* out; unsigned char* ws;
};
__device__ __forceinline__ float wave_sum(float v) {
#pragma unroll
    for (int o = 1; o < 64; o <<= 1) v += __shfl_xor(v, o);
    return v;
}
__device__ __forceinline__ void tr_item(const float* W, int ldw, int K, const float* gain, bf16* WT, int dstrow, LAS float* scr, int k0, int n0, int lane) {
#pragma unroll 8
    for (int i = 0; i < 32; ++i) { const int kk = 2 * i + (lane >> 5); float v = W[(size_t)(k0 + kk) * ldw + n0 + (lane & 31)]; if (gain) v *= gain[k0 + kk]; scr[kk * 33 + (lane & 31)] = v; }
    LDS_WAIT(); asm volatile("" ::: "memory");
    const int c = lane & 7;
#pragma unroll
    for (int j = 0; j < 4; ++j) { const int n = (lane >> 3) + 8 * j; const LAS float* s = scr + (8 * c) * 33 + n;
        v4u o; o.x = pk2(s[0 * 33], s[1 * 33]); o.y = pk2(s[2 * 33], s[3 * 33]); o.z = pk2(s[4 * 33], s[5 * 33]); o.w = pk2(s[6 * 33], s[7 * 33]);
        *(GAS v4u*)(WT + (size_t)(dstrow + n) * K + k0 + 8 * c) = o; }
    LDS_WAIT(); asm volatile("" ::: "memory");
}
__device__ __forceinline__ int hp_row(int a) { const int ap = a & 255; return (a & ~255) + ((ap >> 5) & 1) * 128 + (ap >> 6) * 32; }
__device__ __forceinline__ void cvt_moe_layer(Frame& F, int layer) {
    LAS float* scr = (LAS float*)(F.lds + RING_OFF + F.wave * 16384);
    const int gw = F.vcu * NWAVES + F.wave, NGW = F.G * NWAVES;
    const float* w1 = F.in[21] + (size_t)layer * NE * D * DE; const float* w3 = F.in[22] + (size_t)layer * NE * D * DE; const float* w2 = F.in[23] + (size_t)layer * NE * DE * D;
    const float* mg = F.in[16] + layer * D; bf16* W13 = (bf16*)(F.ws + WS_W13); bf16* W2 = (bf16*)(F.ws + WS_W2);
    for (int it = gw; it < NE * 768; it += NGW) {
        const int e = it / 768, r = it % 768, which = r >> 8, sub = r & 255;
        if (which < 2) { const int kb = sub >> 4, nb = sub & 15, c = 32 * nb; const int dst = e * 1024 + 256 * (c >> 7) + (c & 127) + which * 128;
            tr_item((which ? w3 : w1) + (size_t)e * D * DE, DE, D, mg, W13, dst, scr, 64 * kb, 32 * nb, F.lane); }
        else { const int kb = sub >> 5, nb = sub & 31; tr_item(w2 + (size_t)e * DE * D, D, DE, nullptr, W2, e * 1024 + 32 * nb, scr, 64 * kb, 32 * nb, F.lane); }
    }
}
__device__ __forceinline__ void p0_prologue(Frame& F) {
    LAS float* scr = (LAS float*)(F.lds + RING_OFF + F.wave * 16384);
    const int gw = F.vcu * NWAVES + F.wave, NGW = F.G * NWAVES;
    bf16* WIN = (bf16*)(F.ws + WS_WIN); bf16* WOUT = (bf16*)(F.ws + WS_WOUT); bf16* WKVQG = (bf16*)(F.ws + WS_WKVQG); bf16* WO = (bf16*)(F.ws + WS_WO);
    { float* rstd = (float*)(F.ws + WS_RSTD); bf16* XB = (bf16*)(F.ws + WS_XB);
      for (int m = gw; m < T; m += NGW) { const GAS f32x4* xr = (const GAS f32x4*)(F.in[0] + (size_t)m * D) + F.lane; f32x4 v[4]; float s = 0.f;
#pragma unroll
          for (int j = 0; j < 4; ++j) { v[j] = xr[64 * j]; s += pg8::sq4(v[j]); }
          s = wave_sum(s); if (F.lane == 0) rstd[m] = 1.0f / sqrtf(s * (1.f / D) + EPS);
          GAS v2u* o8 = (GAS v2u*)(XB + (size_t)m * D) + F.lane;
#pragma unroll
          for (int j = 0; j < 4; ++j) o8[64 * j] = (v2u){pk2(v[j][0], v[j][1]), pk2(v[j][2], v[j][3])}; } }
    constexpr int I1 = 16 * 128, I2 = 32 * 32, I3 = 16 * 32;
    for (int it = gw; it < I1 + I2 + 5 * I3; it += NGW) {
        int r = it;
        if (r < I1) { const int kb = r >> 7, nb = r & 127; tr_item(F.in[2], ZW, D, F.in[1], WIN, 32 * nb, scr, 64 * kb, 32 * nb, F.lane); continue; } r -= I1;
        if (r < I2) { const int kb = r >> 5, nb = r & 31; tr_item(F.in[7], D, SW, nullptr, WOUT, 32 * nb, scr, 64 * kb, 32 * nb, F.lane); continue; } r -= I2;
        const int job = r / I3, rr = r % I3, kb = rr >> 5, nb = rr & 31;
        if (job == 0) tr_item(F.in[9], KVW, D, F.in[8], WKVQG, hp_row(32 * nb), scr, 64 * kb, 32 * nb, F.lane);
        else if (job == 1) tr_item(F.in[9], KVW, D, F.in[8], WKVQG, 1024 + hp_row(32 * nb), scr, 64 * kb, 1024 + 32 * nb, F.lane);
        else if (job == 2) tr_item(F.in[13], 2 * D, D, F.in[12], WKVQG, 2048 + hp_row(32 * nb), scr, 64 * kb, 32 * nb, F.lane);
        else if (job == 3) tr_item(F.in[13], 2 * D, D, F.in[12], WKVQG, 3072 + hp_row(32 * nb), scr, 64 * kb, 1024 + 32 * nb, F.lane);
        else tr_item(F.in[15], D, D, nullptr, WO, 32 * nb, scr, 64 * kb, 32 * nb, F.lane);
    }
    { const int gt = F.vcu * (NWAVES * 64) + F.tid, NGT = F.G * NWAVES * 64;
      float* WFT = (float*)(F.ws + WS_WFT); float* WRT = (float*)(F.ws + WS_WRT); bf16* WSM = (bf16*)(F.ws + WS_WSM);
      for (int i = gt; i < H * D; i += NGT) { const int h = i >> 10, k = i & 1023; WFT[i] = F.in[9][(size_t)k * KVW + 2 * D + h] * F.in[8][k]; }
      for (int i = gt; i < 2 * 48 * D; i += NGT) { const int l = i / (48 * D), j = (i >> 10) % 48, k = i & 1023; const float g = F.in[16][l * D + k];
          float v = 0.f; if (j < 32) v = F.in[19][((size_t)l * D + k) * NE + j] * g; else if (j < 36) v = F.in[17][((size_t)l * D + k) * NG + (j - 32)] * g; WRT[i] = v; }
      for (int i = gt; i < 8 * 128 * 128; i += NGT) { const int t = (i >> 7) & 127, s = i & 127; const float v = (t < 64 && s >= 64) ? 0.f : F.in[5][i]; WSM[i] = (bf16)(pk2(v, 0.f) & 0xffffu); } }
    cvt_moe_layer(F, 0);
}
constexpr int SG_WSTR = 272, SG_VSTR = 524;
constexpr int SG_WOFF = 0, SG_VOFF = 128 * SG_WSTR, SG_ROFF = SG_VOFF + 128 * SG_VSTR;
static_assert(SG_ROFF + 512 <= RING_BYTES, "sgu LDS");
__device__ __forceinline__ void sgu_phase(Frame& F) {
    const bf16* Z = (const bf16*)(F.ws + WS_BIG); bf16* GY = (bf16*)(F.ws + WS_GY); const bf16* WSM = (const bf16*)(F.ws + WS_WSM); const float* ssv = (const float*)(F.ws + WS_SSV);
    const float* gvn = F.in[4]; const float* bs = F.in[6];
    LAS unsigned char* L = F.lds + RING_OFF; LAS float* rs = (LAS float*)(L + SG_ROFF);
    const int tid = F.tid, lane = F.lane, w = F.wave, n15 = lane & 15, kq = lane >> 4;
    int gloaded = -1;
    for (int u = F.vcu; u < (T / 128) * 8; u += F.G) {
        const int g = u & 7, nb = u >> 3;
        if (g != gloaded) {
#pragma unroll
            for (int j = 0; j < 4; ++j) { const int idx = tid + 512 * j, row = idx >> 4, cc = idx & 15;
                *(LAS v4u*)(L + SG_WOFF + row * SG_WSTR + cc * 16) = *(const v4u*)(WSM + (size_t)g * 16384 + row * 128 + cc * 8); }
            gloaded = g; }
        if (tid < 128) { const float* p = ssv + (size_t)(nb * 128 + tid) * 32; float s = 0.f;
#pragma unroll
            for (int j = 0; j < 8; ++j) { const f32x4 v = *(const f32x4*)(p + 4 * j); s += (v[0] + v[1]) + (v[2] + v[3]); }
            rs[tid] = 1.0f / sqrtf(s * (1.f / SW) + EPS); }
        __syncthreads();
#pragma unroll
        for (int j = 0; j < 8; ++j) { const int idx = tid + 512 * j, s = idx >> 5, cc = idx & 31;
            const v4u raw = *(const v4u*)(Z + (size_t)(nb * 128 + s) * ZW + SW + 256 * g + 8 * cc); const float r = rs[s];
            LAS unsigned* dst = (LAS unsigned*)(L + SG_VOFF + s * SG_VSTR + cc * 16);
            dst[0] = pk2(bf_lo(raw.x) * r, bf_hi(raw.x) * r); dst[1] = pk2(bf_lo(raw.y) * r, bf_hi(raw.y) * r); dst[2] = pk2(bf_lo(raw.z) * r, bf_hi(raw.z) * r); dst[3] = pk2(bf_lo(raw.w) * r, bf_hi(raw.w) * r); }
        __syncthreads();
        f32x4 acc[8][2];
#pragma unroll
        for (int mt = 0; mt < 8; ++mt) { acc[mt][0] = (f32x4){0.f, 0.f, 0.f, 0.f}; acc[mt][1] = (f32x4){0.f, 0.f, 0.f, 0.f}; }
#pragma unroll
        for (int ks = 0; ks < 4; ++ks) {
            bf16x8 vf[2];
#pragma unroll
            for (int nt = 0; nt < 2; ++nt) { const LAS unsigned short* vp = (const LAS unsigned short*)(L + SG_VOFF) + (32 * ks + 8 * kq) * (SG_VSTR / 2) + 32 * w + 16 * nt + n15;
#pragma unroll
                for (int j = 0; j < 8; ++j) vf[nt][j] = (short)vp[j * (SG_VSTR / 2)]; }
#pragma unroll
            for (int mt = 0; mt < 8; ++mt) if (mt >= 4 || ks < 2) {
                const bf16x8 wf = *(const LAS bf16x8*)(L + SG_WOFF + (16 * mt + n15) * SG_WSTR + (32 * ks + 8 * kq) * 2);
                acc[mt][0] = __builtin_amdgcn_mfma_f32_16x16x32_bf16(vf[0], wf, acc[mt][0], 0, 0, 0); acc[mt][1] = __builtin_amdgcn_mfma_f32_16x16x32_bf16(vf[1], wf, acc[mt][1], 0, 0, 0); }
        }
#pragma unroll
        for (int mt = 0; mt < 8; ++mt) { const int t = 16 * mt + n15; const float bst = bs[g * 128 + t]; const size_t row = (size_t)nb * 128 + t;
#pragma unroll
            for (int nt = 0; nt < 2; ++nt) { const int c0 = 256 * g + 32 * w + 16 * nt + 4 * kq; const f32x4 gv = *(const f32x4*)(gvn + c0); const v2u uu = *(const v2u*)(Z + row * ZW + c0);
                const f32x4 a = acc[mt][nt];
                const float o0 = bf_lo(uu.x) * (gv[0] * a[0] + bst), o1 = bf_hi(uu.x) * (gv[1] * a[1] + bst), o2 = bf_lo(uu.y) * (gv[2] * a[2] + bst), o3 = bf_hi(uu.y) * (gv[3] * a[3] + bst);
                *(v2u*)(GY + row * SW + c0) = (v2u){pk2(o0, o1), pk2(o2, o3)}; } }
        __syncthreads();
    }
}
__device__ __forceinline__ void route_phase(Frame& F, int layer) {
    const float* X = F.out; const float* WRT = (const float*)(F.ws + WS_WRT) + (size_t)layer * 48 * D;
    const float* bg = F.in[18] + layer * NG; const float* be = F.in[20] + layer * NE;
    int* LA = (int*)(F.ws + WS_LA); float* LW = (float*)(F.ws + WS_LW); float* LR = (float*)(F.ws + WS_LR);
    LAS unsigned char* L = F.lds + RING_OFF;
    LAS float* lg = (LAS float*)L + F.wave * (16 * 48);
    LAS int* lcnt = (LAS int*)(L + 16384); LAS int* lbase = lcnt + 32; LAS int* sel_e = lcnt + 64; LAS int* sel_rk = lcnt + 192; LAS float* sel_w = (LAS float*)(lcnt + 320); LAS float* sel_r = (LAS float*)(lcnt + 448);
    const int tid = F.tid, lane = F.lane, m = lane & 15, kq = lane >> 4;
    for (int grp = F.vcu; grp < T / 64; grp += F.G) {
        if (tid < 32) lcnt[tid] = 0;
        __syncthreads();
        if (F.wave < 4) {
            const int r0 = grp * 64 + F.wave * 16;
            const float* xr = X + (size_t)(r0 + m) * D + 4 * kq; const float* w0 = WRT + (size_t)m * D + 4 * kq;
            f32x4 a0 = (f32x4){0.f, 0.f, 0.f, 0.f}, a1 = a0, a2 = a0; float ss = 0.f;
#pragma unroll 4
            for (int J = 0; J < 64; ++J) { const f32x4 xv = *(const f32x4*)(xr + 16 * J); const f32x4 b0 = *(const f32x4*)(w0 + 16 * J), b1 = *(const f32x4*)(w0 + 16 * D + 16 * J), b2 = *(const f32x4*)(w0 + 32 * D + 16 * J);
                ss += pg8::sq4(xv);
#pragma unroll
                for (int i = 0; i < 4; ++i) { a0 = __builtin_amdgcn_mfma_f32_16x16x4f32(xv[i], b0[i], a0, 0, 0, 0); a1 = __builtin_amdgcn_mfma_f32_16x16x4f32(xv[i], b1[i], a1, 0, 0, 0); a2 = __builtin_amdgcn_mfma_f32_16x16x4f32(xv[i], b2[i], a2, 0, 0, 0); } }
            ss += __shfl_xor(ss, 16); ss += __shfl_xor(ss, 32);
            const float rstd = 1.0f / sqrtf(ss * (1.f / D) + EPS);
#pragma unroll
            for (int i = 0; i < 4; ++i) { const float rr = __shfl(rstd, 4 * kq + i); LAS float* p = lg + (4 * kq + i) * 48 + m; p[0] = a0[i] * rr; p[16] = a1[i] * rr; p[32] = a2[i] * rr; }
            LDS_WAIT(); asm volatile("" ::: "memory");
            if (lane < 16) {
                const LAS float* lr = lg + lane * 48;
                float gl[4];
#pragma unroll
                for (int j = 0; j < 4; ++j) gl[j] = lr[32 + j] + bg[j];
                int gs = 0; float gm = gl[0];
#pragma unroll
                for (int j = 1; j < 4; ++j) if (gl[j] > gm) { gm = gl[j]; gs = j; }
                float gsum = 0.f;
#pragma unroll
                for (int j = 0; j < 4; ++j) gsum += __expf(gl[j] - gm);
                const float gw = 1.f / gsum;
                float el[8];
#pragma unroll
                for (int j = 0; j < 8; ++j) el[j] = lr[gs * 8 + j] + be[gs * 8 + j];
                int i0 = 0; float v0 = el[0];
#pragma unroll
                for (int j = 1; j < 8; ++j) if (el[j] > v0) { v0 = el[j]; i0 = j; }
                int i1 = -1; float v1 = -INFINITY;
#pragma unroll
                for (int j = 0; j < 8; ++j) if (j != i0 && el[j] > v1) { v1 = el[j]; i1 = j; }
                const float p1 = __expf(v1 - v0), w0_ = 1.f / (1.f + p1), w1_ = p1 * w0_;
                const int e0 = gs * 8 + i0, e1 = gs * 8 + i1, q = F.wave * 16 + lane;
                sel_e[2 * q] = e0; sel_e[2 * q + 1] = e1; sel_w[2 * q] = gw * w0_; sel_w[2 * q + 1] = gw * w1_; sel_r[q] = rstd;
                sel_rk[2 * q] = __hip_atomic_fetch_add(lcnt + e0, 1, __ATOMIC_RELAXED, __HIP_MEMORY_SCOPE_WORKGROUP);
                sel_rk[2 * q + 1] = __hip_atomic_fetch_add(lcnt + e1, 1, __ATOMIC_RELAXED, __HIP_MEMORY_SCOPE_WORKGROUP);
            }
        }
        __syncthreads();
        if (tid < 32) { const int c = lcnt[tid]; lbase[tid] = c ? (int)__hip_atomic_fetch_add(F.ctl + CW_CNT + (layer * 32 + tid) * 64, (unsigned)c, RLX_AGENT) : 0; }
        __syncthreads();
        if (tid < 128) { const int e = sel_e[tid]; const int pos = lbase[e] + sel_rk[tid]; const size_t o = (size_t)e * LCAP + pos;
            LA[o] = 2 * (grp * 64 + (tid >> 1)) + (tid & 1); LW[o] = sel_w[tid]; LR[o] = sel_r[tid >> 1]; }
        __syncthreads();
    }
}
template <bool G1> __device__ __forceinline__ int moe_setup(Frame& F, int layer) {
    LAS int* mt = (LAS int*)(F.lds + TAB_OFF); LAS int* hb = mt + 32; LAS int* cl = mt + 64; LAS int* tot = mt + 96;
    LAS int* tabA = (LAS int*)(F.lds + TABA_OFF); LAS float* tabF = (LAS float*)(F.lds + TABF_OFF);
    const int* LA = (const int*)(F.ws + WS_LA); const float* LW = (const float*)(F.ws + WS_LW); const float* LR = (const float*)(F.ws + WS_LR);
    if (F.tid < 32) { const int c = (int)__hip_atomic_load(F.ctl + CW_CNT + (layer * 32 + F.tid) * 64, RLX_AGENT); cl[F.tid] = c; mt[F.tid] = (c + 255) >> 8; }
    __syncthreads();
    if (F.tid == 0) { int s = 0; for (int e = 0; e < 32; ++e) { hb[e] = 256 * s; s += mt[e]; } tot[0] = 4 * s; }
    __syncthreads();
    const int total = tot[0];
    for (int idx = F.tid; idx < 3 * 256; idx += NWAVES * 64) {
        const int slot = idx >> 8, r = idx & 255; int Lx = slot * F.G + F.vcu; int a = G1 ? 0 : -1; float f = 0.f;
        if (Lx < total) { int e = 0; for (; e < 31; ++e) { const int ue = 4 * mt[e]; if (Lx < ue) break; Lx -= ue; }
            const int m = mt[e], pn = Lx / m, pm = Lx - pn * m, pos = 256 * pm + r;
            if (pos < cl[e]) { const size_t o = (size_t)e * LCAP + pos; const int av = LA[o]; a = G1 ? (av >> 1) : av; f = G1 ? LR[o] : LW[o]; } }
        tabA[idx] = a; tabF[idx] = f;
    }
    __syncthreads();
    return total;
}
__device__ __forceinline__ void combine0_phase(Frame& F) {
    const bf16* Y2 = (const bf16*)(F.ws + WS_GY); bf16* XB = (bf16*)(F.ws + WS_XB); float* rstd = (float*)(F.ws + WS_RSTD); float* LF = (float*)(F.ws + WS_LF);
    const float* WFT = (const float*)(F.ws + WS_WFT); const float* bfv = F.in[10];
    LAS float* cs = (LAS float*)(F.lds + RING_OFF); LAS f32x4* cf = (LAS f32x4*)(F.lds + RING_OFF + 1024);
    const int lane = F.lane, m = lane & 15, kq = lane >> 4, tile = F.wave & 3, kh = F.wave >> 2;
    for (int grp = F.vcu; grp < T / 64; grp += F.G) {
        const int r0 = grp * 64 + tile * 16;
        float* xr = F.out + (size_t)(r0 + m) * D + kh * 512 + 4 * kq; const bf16* ya = Y2 + (size_t)(2 * (r0 + m)) * D + kh * 512 + 4 * kq; const bf16* yb = ya + D;
        bf16* xb = XB + (size_t)(r0 + m) * D + kh * 512 + 4 * kq; const float* wf = WFT + (size_t)m * D + kh * 512 + 4 * kq;
        f32x4 fa = (f32x4){0.f, 0.f, 0.f, 0.f}; float ss = 0.f;
#pragma unroll 4
        for (int J = 0; J < 32; ++J) { const f32x4 xv = *(const f32x4*)(xr + 16 * J); const v2u a = *(const v2u*)(ya + 16 * J), b = *(const v2u*)(yb + 16 * J); const f32x4 wv = *(const f32x4*)(wf + 16 * J);
            f32x4 x2; x2[0] = xv[0] + bf_lo(a.x) + bf_lo(b.x); x2[1] = xv[1] + bf_hi(a.x) + bf_hi(b.x); x2[2] = xv[2] + bf_lo(a.y) + bf_lo(b.y); x2[3] = xv[3] + bf_hi(a.y) + bf_hi(b.y);
            *(f32x4*)(xr + 16 * J) = x2; *(v2u*)(xb + 16 * J) = (v2u){pk2(x2[0], x2[1]), pk2(x2[2], x2[3])}; ss += pg8::sq4(x2);
#pragma unroll
            for (int i = 0; i < 4; ++i) fa = __builtin_amdgcn_mfma_f32_16x16x4f32(x2[i], wv[i], fa, 0, 0, 0); }
        ss += __shfl_xor(ss, 16); ss += __shfl_xor(ss, 32);
        if (kh == 1) { if (lane < 16) cs[tile * 16 + lane] = ss; cf[tile * 64 + lane] = fa; }
        __syncthreads();
        if (kh == 0) { ss += cs[tile * 16 + m]; fa = fa + cf[tile * 64 + lane];
            const float rs = 1.0f / sqrtf(ss * (1.f / D) + EPS); if (lane < 16) rstd[r0 + lane] = rs;
            f32x4 o; const float bb = bfv[m];
#pragma unroll
            for (int i = 0; i < 4; ++i) { const float f = fa[i] * __shfl(rs, 4 * kq + i) + bb; o[i] = fminf(f, 0.f) - log1pf(__expf(-fabsf(f))); }
            const int b = r0 / S, t0 = r0 % S; *(f32x4*)(LF + ((size_t)(b * H + m)) * S + t0 + 4 * kq) = o; }
        __syncthreads();
    }
}
__device__ __forceinline__ void cumsum_seq(Frame& F, int seq) {
    const float* lf = (const float*)(F.ws + WS_LF) + (size_t)seq * S; float* cum = (float*)(F.ws + WS_CUM) + (size_t)seq * S;
    LAS float* wt = (LAS float*)(F.lds + RING_OFF);
    const f32x4 a = *(const f32x4*)(lf + 8 * F.tid), b = *(const f32x4*)(lf + 8 * F.tid + 4);
    float p[8]; p[0] = a[0]; p[1] = p[0] + a[1]; p[2] = p[1] + a[2]; p[3] = p[2] + a[3]; p[4] = p[3] + b[0]; p[5] = p[4] + b[1]; p[6] = p[5] + b[2]; p[7] = p[6] + b[3];
    float incl = p[7];
#pragma unroll
    for (int o = 1; o < 64; o <<= 1) { const float v = __shfl_up(incl, o); if (F.lane >= o) incl += v; }
    if (F.lane == 63) wt[F.wave] = incl;
    __syncthreads();
    float base = incl - p[7];
    for (int w = 0; w < F.wave; ++w) base += wt[w];
    *(f32x4*)(cum + 8 * F.tid) = (f32x4){p[0] + base, p[1] + base, p[2] + base, p[3] + base}; *(f32x4*)(cum + 8 * F.tid + 4) = (f32x4){p[4] + base, p[5] + base, p[6] + base, p[7] + base};
    __syncthreads();
}
__device__ __forceinline__ void final_phase(Frame& F) {
    const bf16* Y2 = (const bf16*)(F.ws + WS_GY); const int gw = F.vcu * NWAVES + F.wave, NGW = F.G * NWAVES;
    for (int m = gw; m < T; m += NGW) { GAS f32x4* xr = (GAS f32x4*)(F.out + (size_t)m * D) + F.lane; const GAS v2u* ya = (const GAS v2u*)(Y2 + (size_t)(2 * m) * D) + F.lane; const GAS v2u* yb = ya + D / 4;
#pragma unroll
        for (int j = 0; j < 4; ++j) { const f32x4 xv = xr[64 * j]; const v2u a = ya[64 * j], b = yb[64 * j];
            xr[64 * j] = (f32x4){xv[0] + bf_lo(a.x) + bf_lo(b.x), xv[1] + bf_hi(a.x) + bf_hi(b.x), xv[2] + bf_lo(a.y) + bf_lo(b.y), xv[3] + bf_hi(a.y) + bf_hi(b.y)}; } }
}

struct Args { const float* in[24]; float* out; unsigned char* ws; int ph_lo, ph_hi; };
__global__ void __launch_bounds__(NWAVES * 64, 2) fwd(Args args) {
    extern __shared__ __attribute__((aligned(16))) unsigned char lds[];
    Frame F;
    F.lds = (LAS unsigned char*)lds; F.MISC = (volatile LAS unsigned*)(F.lds + MISC_OFF);
    F.tid = threadIdx.x; F.lane = F.tid & 63; F.wave = __builtin_amdgcn_readfirstlane(F.tid >> 6);
    F.G = gridDim.x; { const int bx = blockIdx.x; F.vcu = (F.G % 8 == 0) ? (bx % 8) * (F.G / 8) + bx / 8 : bx; }
    F.ws = args.ws; F.ctl = (gu32*)(args.ws + WS_CTL); F.out = args.out;
#pragma unroll
    for (int i = 0; i < 24; ++i) F.in[i] = args.in[i];
    for (int u = F.tid; u < (TAB_OFF - LDSCTL_OFF) / 4; u += NWAVES * 64) ((LAS unsigned*)(F.lds + LDSCTL_OFF))[u] = 0u;
    __syncthreads();
#if MK_PER_PHASE
#define GRID_BAR() do { } while (0)
#else
    XcdBarrier bar = xcd_barrier_post((unsigned*)(F.ctl + CW_BAR), F.MISC + 8);
#define GRID_BAR() xcd_barrier(bar)
#endif
    const int lo = args.ph_lo, hi = args.ph_hi;
#define IN(k) (lo <= (k) && (k) < hi)
#define SEAM(k) do { if (IN(k) && IN((k) + 1)) GRID_BAR(); } while (0)
    bf16* XB = (bf16*)(F.ws + WS_XB); float* RSTD = (float*)(F.ws + WS_RSTD);
    bf16* ZB = (bf16*)(F.ws + WS_BIG); bf16* GY = (bf16*)(F.ws + WS_GY); bf16* HID = (bf16*)(F.ws + WS_HID);
    bf16* KB = ZB; bf16* VB = ZB + (size_t)T * D; bf16* QB = ZB + (size_t)2 * T * D; bf16* GB = ZB + (size_t)3 * T * D;
    LAS int* mt = (LAS int*)(F.lds + TAB_OFF); LAS int* hb = mt + 32; LAS int* tabA = (LAS int*)(F.lds + TABA_OFF); LAS float* tabF = (LAS float*)(F.lds + TABF_OFF);

    if (IN(0)) { p0_prologue(F); } SEAM(0);
    if (IN(1)) { pg8::DenseOrder So; So.init(T, ZW, F.G, (int)blockIdx.x); pg8::EpiIn E{ZB, RSTD, F.in[3], (float*)(F.ws + WS_SSV)};
        pg8::gemm_phase<pg8::EpiIn, pg8::DenseOrder, true, true>(F.lds + RING_OFF, XB, (const bf16*)(F.ws + WS_WIN), D, So, E); } SEAM(1);
    if (IN(2)) { sgu_phase(F); } SEAM(2);
    if (IN(3)) { pg8::DenseOrder So; So.init(T, D, F.G, (int)blockIdx.x); pg8::EpiRes E{F.in[0], F.out, XB};
        pg8::gemm_phase<pg8::EpiRes, pg8::DenseOrder, true, true>(F.lds + RING_OFF, GY, (const bf16*)(F.ws + WS_WOUT), SW, So, E); } SEAM(3);
    if (IN(4)) { route_phase(F, 0); } SEAM(4);
    if (IN(5)) { const int total = moe_setup<true>(F, 0); pg8::MoeOrder<true> So{mt, hb, tabA, total, F.G, F.vcu}; pg8::EpiMoe1 E{HID, tabF};
        pg8::gemm_phase<pg8::EpiMoe1, pg8::MoeOrder<true>, true, true>(F.lds + RING_OFF, XB, (const bf16*)(F.ws + WS_W13), D, So, E); } SEAM(5);
    if (IN(6)) { const int total = moe_setup<false>(F, 0); pg8::MoeOrder<false> So{mt, hb, tabA, total, F.G, F.vcu}; pg8::EpiMoe2 E{GY, tabA, tabF};
        pg8::gemm_phase<pg8::EpiMoe2, pg8::MoeOrder<false>, true, true>(F.lds + RING_OFF, HID, (const bf16*)(F.ws + WS_W2), DE, So, E); } SEAM(6);
    if (IN(7)) { combine0_phase(F); cvt_moe_layer(F, 1); } SEAM(7);
    if (IN(8)) { for (int sq = F.vcu; sq < NB * H; sq += F.G) cumsum_seq(F, sq);
        pg8::DenseOrder So; So.init(T, 4 * D, F.G, (int)blockIdx.x); pg8::EpiKVQG E{KB, RSTD, F.in[11], F.in[14]};
        pg8::gemm_phase<pg8::EpiKVQG, pg8::DenseOrder, true, true>(F.lds + RING_OFF, XB, (const bf16*)(F.ws + WS_WKVQG), D, So, E); } SEAM(8);
    if (IN(9)) { float gq = fabsf(F.in[14][F.lane]), gk = fabsf(F.in[11][F.lane]);
#pragma unroll
        for (int o = 1; o < 64; o <<= 1) { gq = fmaxf(gq, __shfl_xor(gq, o)); gk = fmaxf(gk, __shfl_xor(gk, o)); }
        const float TH = 104.f + 16.f * gq * gk * 1.02f + 4.f;
        const attn_body::AttnTensors AT{(const attn_body::bf16*)QB, (const attn_body::bf16*)KB, (const attn_body::bf16*)VB, (const attn_body::bf16*)GB, (const float*)(F.ws + WS_CUM), TH, (attn_body::bf16*)QB};
        const attn_body::StaticOrder Sa((int)F.G, (int)blockIdx.x);
        attn_body::attn_phase<attn_body::StaticOrder>((char*)lds + RING_OFF, AT, Sa); } SEAM(9);
    if (IN(10)) { pg8::DenseOrder So; So.init(T, D, F.G, (int)blockIdx.x); pg8::EpiRes E{F.out, F.out, XB};
        pg8::gemm_phase<pg8::EpiRes, pg8::DenseOrder, true, true>(F.lds + RING_OFF, QB, (const bf16*)(F.ws + WS_WO), D, So, E); } SEAM(10);
    if (IN(11)) { route_phase(F, 1); } SEAM(11);
    if (IN(12)) { const int total = moe_setup<true>(F, 1); pg8::MoeOrder<true> So{mt, hb, tabA, total, F.G, F.vcu}; pg8::EpiMoe1 E{HID, tabF};
        pg8::gemm_phase<pg8::EpiMoe1, pg8::MoeOrder<true>, true, true>(F.lds + RING_OFF, XB, (const bf16*)(F.ws + WS_W13), D, So, E); } SEAM(12);
    if (IN(13)) { const int total = moe_setup<false>(F, 1); pg8::MoeOrder<false> So{mt, hb, tabA, total, F.G, F.vcu}; pg8::EpiMoe2 E{GY, tabA, tabF};
        pg8::gemm_phase<pg8::EpiMoe2, pg8::MoeOrder<false>, true, true>(F.lds + RING_OFF, HID, (const bf16*)(F.ws + WS_W2), DE, So, E); } SEAM(13);
    if (IN(14)) { final_phase(F); }
#undef IN
#undef SEAM
}


#if DBG
namespace nv {

__global__ void rmsnorm(const float* x, int ldx, const float* g, float* y, int ldy, int W) {
    const int r = blockIdx.x; const float* xr = x + (size_t)r * ldx;
    float s = 0.f; for (int c = threadIdx.x; c < W; c += 256) { const float v = xr[c]; s += v * v; }
    __shared__ float red[256]; red[threadIdx.x] = s; __syncthreads();
    for (int o = 128; o > 0; o >>= 1) { if ((int)threadIdx.x < o) red[threadIdx.x] += red[threadIdx.x + o]; __syncthreads(); }
    const float rs = rsqrtf(red[0] / (float)W + EPS);
    for (int c = threadIdx.x; c < W; c += 256) y[(size_t)r * ldy + c] = xr[c] * rs * g[c];
}
__global__ void headnorm(float* x, int ld, const float* g) {
    const int r = blockIdx.x, c = threadIdx.x; float v = x[(size_t)r * ld + c]; float s = v * v;
    for (int o = 1; o < 64; o <<= 1) s += __shfl_xor(s, o);
    x[(size_t)r * ld + c] = v * rsqrtf(s / 64.f + EPS) * g[c & 63];
}
__device__ __forceinline__ float gelu_tanh(float v) { return 0.5f * v * (1.f + tanhf(0.7978845608028654f * (v + 0.044715f * v * v * v))); }
template <int MODE> __global__ void gemm(const float* A, int lda, const float* Bm, int ldb, float* C, int ldc, const float* bias, const float* R, int ldr, int M, int N, int K) {
    __shared__ float As[16][68], Bs[16][68];
    const int tx = threadIdx.x % 16, ty = threadIdx.x / 16, m0 = blockIdx.y * 64, n0 = blockIdx.x * 64;
    float acc[4][4] = {};
    for (int k0 = 0; k0 < K; k0 += 16) {
        for (int i = threadIdx.x; i < 1024; i += 256) { const int m = i / 16, k = i % 16; As[k][m] = A[(size_t)(m0 + m) * lda + k0 + k]; }
        for (int i = threadIdx.x; i < 1024; i += 256) { const int k = i / 64, n = i % 64; Bs[k][n] = (n0 + n < N) ? Bm[(size_t)(k0 + k) * ldb + n0 + n] : 0.f; }
        __syncthreads();
#pragma unroll
        for (int k = 0; k < 16; ++k) {
            float a[4], b[4];
#pragma unroll
            for (int i = 0; i < 4; ++i) { a[i] = As[k][ty * 4 + i]; b[i] = Bs[k][tx * 4 + i]; }
#pragma unroll
            for (int i = 0; i < 4; ++i)
#pragma unroll
                for (int j = 0; j < 4; ++j) acc[i][j] += a[i] * b[j];
        }
        __syncthreads();
    }
    for (int i = 0; i < 4; ++i) for (int j = 0; j < 4; ++j) {
        const int m = m0 + ty * 4 + i, n = n0 + tx * 4 + j; if (n >= N) continue;
        float v = acc[i][j]; if (bias) v += bias[n]; if (MODE == 1) v = gelu_tanh(v); if (MODE == 2) v += R[(size_t)m * ldr + n];
        C[(size_t)m * ldc + n] = v;
    }
}
__global__ void sgu(const float* z, const float* w_s, const float* b_s, float* gated) {
    const int c = blockIdx.x * 256 + threadIdx.x, t = blockIdx.y, g = c / 256, blk = t / 128, tt = t % 128;
    const float* W = w_s + ((size_t)g * 128 + tt) * 128; float acc = 0.f; const int smax = (tt < 64) ? 64 : 128;
    for (int s = 0; s < smax; ++s) acc += W[s] * z[(size_t)(blk * 128 + s) * ZW + SW + c];
    gated[(size_t)t * SW + c] = z[(size_t)t * ZW + c] * (acc + b_s[g * 128 + tt]);
}
__global__ void route(const float* xn, const float* wg, const float* bg, const float* we, const float* be, int* eid, float* ew) {
    const int t = blockIdx.x, l = threadIdx.x; __shared__ float part[64][37]; __shared__ float lg[36];
    float a[36]; for (int j = 0; j < 36; ++j) a[j] = 0.f;
    for (int k = l; k < D; k += 64) { const float xv = xn[(size_t)t * D + k];
        for (int j = 0; j < 32; ++j) a[j] += xv * we[(size_t)k * NE + j];
        for (int j = 0; j < 4; ++j) a[32 + j] += xv * wg[(size_t)k * NG + j]; }
    for (int j = 0; j < 36; ++j) part[l][j] = a[j];
    __syncthreads();
    if (l < 36) { float s = 0.f; for (int i = 0; i < 64; ++i) s += part[i][l]; lg[l] = s + (l < 32 ? be[l] : bg[l - 32]); }
    __syncthreads();
    if (l == 0) {
        int gs = 0; float gm = lg[32]; for (int j = 1; j < 4; ++j) if (lg[32 + j] > gm) { gm = lg[32 + j]; gs = j; }
        float gsum = 0.f; for (int j = 0; j < 4; ++j) gsum += expf(lg[32 + j] - gm); const float gw = 1.f / gsum;
        const float* el = lg + gs * EPG; int i0 = 0; for (int j = 1; j < EPG; ++j) if (el[j] > el[i0]) i0 = j;
        int i1 = (i0 == 0) ? 1 : 0; for (int j = 0; j < EPG; ++j) if (j != i0 && el[j] > el[i1]) i1 = j;
        const float p1 = expf(el[i1] - el[i0]); const float w0 = 1.f / (1.f + p1), w1 = p1 / (1.f + p1);
        eid[2 * t] = gs * EPG + i0; eid[2 * t + 1] = gs * EPG + i1; ew[2 * t] = gw * w0; ew[2 * t + 1] = gw * w1;
    }
}
__global__ void moe_ffn(const float* xn, const float* xres, const int* eid, const float* ew, const float* w1, const float* w3, const float* w2, float* out) {
    __shared__ float xs[1024], hs[512]; const int t = blockIdx.x, tid = threadIdx.x;
    for (int i = tid; i < D; i += 256) xs[i] = xn[(size_t)t * D + i];
    float o[4] = {0.f, 0.f, 0.f, 0.f}; __syncthreads();
    for (int k = 0; k < 2; ++k) { const int e = eid[2 * t + k]; const float w = ew[2 * t + k];
        const float* W1 = w1 + (size_t)e * D * DE; const float* W3 = w3 + (size_t)e * D * DE; const float* W2 = w2 + (size_t)e * DE * D;
        for (int j = tid; j < DE; j += 256) { float a = 0.f, b = 0.f; for (int kk = 0; kk < D; ++kk) { a += xs[kk] * W1[(size_t)kk * DE + j]; b += xs[kk] * W3[(size_t)kk * DE + j]; }
            hs[j] = a / (1.f + expf(-a)) * b; }
        __syncthreads();
        for (int i = 0; i < 4; ++i) { const int n = tid + 256 * i; float y = 0.f; for (int j = 0; j < DE; ++j) y += hs[j] * W2[(size_t)j * D + n]; o[i] += w * y; }
        __syncthreads(); }
    for (int i = 0; i < 4; ++i) { const int n = tid + 256 * i; out[(size_t)t * D + n] = xres[(size_t)t * D + n] + o[i]; }
}
__global__ void logf_k(const float* kvf, const float* bf, float* lf) {
    const int i = blockIdx.x * 256 + threadIdx.x, t = i / H, h = i % H; const float f = kvf[(size_t)t * KVW + 2 * D + h] + bf[h];
    lf[i] = fminf(f, 0.f) - log1pf(expf(-fabsf(f)));
}
__global__ void cumsum_k(const float* lf, float* cum, int n) {
    const int h = threadIdx.x; if (h >= H) return; double s = 0.0; for (int t = 0; t < n; ++t) { s += (double)lf[t * H + h]; cum[h * S + t] = (float)s; }
}
__global__ void attn(const float* qg, const float* kvf, const float* cum, float* ao) {
    const int t = blockIdx.x, h = blockIdx.y, d = threadIdx.x; const float qd = qg[(size_t)t * 2 * D + h * HD + d]; const float ct = cum[h * S + t];
    float m = -INFINITY, l = 0.f, acc = 0.f;
    for (int s = 0; s <= t; ++s) { float p = qd * kvf[(size_t)s * KVW + h * HD + d];
        for (int o = 1; o < 64; o <<= 1) p += __shfl_xor(p, o);
        const float sc = p * 0.125f + ct - cum[h * S + s]; const float mn = fmaxf(m, sc), f = expf(m - mn), e = expf(sc - mn);
        l = l * f + e; acc = acc * f + e * kvf[(size_t)s * KVW + D + h * HD + d]; m = mn; }
    const float gt = qg[(size_t)t * 2 * D + D + h * HD + d];
    ao[(size_t)t * D + h * HD + d] = acc / l / (1.f + expf(-gt));
}
}
namespace nv {
struct Bufs { float *hbuf, *z, *gated, *kvf, *qg, *ao, *lf, *cum; int* eid; float* ew; };
__host__ inline Bufs carve(char* base) { const size_t M = 1u << 20; Bufs b; b.hbuf = (float*)(base); b.z = (float*)(base + 16 * M); b.gated = (float*)(base + 80 * M); b.kvf = (float*)(base + 112 * M);
    b.qg = (float*)(base + 146 * M); b.ao = (float*)(base + 178 * M); b.lf = (float*)(base + 194 * M); b.cum = (float*)(base + 195 * M); b.eid = (int*)(base + 196 * M); b.ew = (float*)(base + 197 * M); return b; }
__host__ inline Bufs carve_small(char* base) { const size_t M = 1u << 20; Bufs b; b.hbuf = (float*)(base); b.z = (float*)(base + 4 * M); b.gated = (float*)(base + 20 * M); b.kvf = (float*)(base + 28 * M);
    b.qg = (float*)(base + 37 * M); b.ao = (float*)(base + 45 * M); b.lf = (float*)(base + 49 * M); b.cum = (float*)(base + 50 * M); b.eid = (int*)(base + 51 * M); b.ew = (float*)(base + 52 * M); return b; }
__global__ void sigm_k(const float* qg, float* o) { const int i = blockIdx.x * 256 + threadIdx.x, t = i / D, c = i % D; o[i] = 1.f / (1.f + expf(-qg[(size_t)t * 2 * D + D + c])); }
inline void run_batch(void* const* d_in, const float* xb, float* ob, const Bufs& B, int n, hipStream_t st, float* const* snap, int* const* seid, float* const* sew) {
    const float* a_norm = (const float*)d_in[1]; const float* a_w_in = (const float*)d_in[2]; const float* a_b_in = (const float*)d_in[3];
    const float* a_v_norm = (const float*)d_in[4]; const float* a_w_s = (const float*)d_in[5]; const float* a_b_s = (const float*)d_in[6]; const float* a_w_out = (const float*)d_in[7];
    const float* kv_norm = (const float*)d_in[8]; const float* kv_w = (const float*)d_in[9]; const float* kv_b_f = (const float*)d_in[10]; const float* k_norm = (const float*)d_in[11];
    const float* b_norm = (const float*)d_in[12]; const float* b_w_qg = (const float*)d_in[13]; const float* q_norm = (const float*)d_in[14]; const float* b_w_out = (const float*)d_in[15];
    const float* m_norm = (const float*)d_in[16]; const float* m_w_group = (const float*)d_in[17]; const float* m_b_group = (const float*)d_in[18]; const float* m_w_expert = (const float*)d_in[19];
    const float* m_b_expert = (const float*)d_in[20]; const float* m_w1 = (const float*)d_in[21]; const float* m_w3 = (const float*)d_in[22]; const float* m_w2 = (const float*)d_in[23];
    const size_t rowb = (size_t)n * D * 4;
    rmsnorm<<<n, 256, 0, st>>>(xb, D, a_norm, B.hbuf, D, D);
    gemm<1><<<dim3(ZW / 64, n / 64), 256, 0, st>>>(B.hbuf, D, a_w_in, ZW, B.z, ZW, a_b_in, nullptr, 0, n, ZW, D);
    rmsnorm<<<n, 256, 0, st>>>(B.z + SW, ZW, a_v_norm, B.z + SW, ZW, SW);
    sgu<<<dim3(SW / 256, n), 256, 0, st>>>(B.z, a_w_s, a_b_s, B.gated);
    gemm<2><<<dim3(D / 64, n / 64), 256, 0, st>>>(B.gated, SW, a_w_out, D, ob, D, nullptr, xb, D, n, D, SW);
    if (snap) (void)hipMemcpyAsync(snap[0], ob, rowb, hipMemcpyDeviceToDevice, st);
    rmsnorm<<<n, 256, 0, st>>>(ob, D, m_norm, B.hbuf, D, D);
    route<<<n, 64, 0, st>>>(B.hbuf, m_w_group, m_b_group, m_w_expert, m_b_expert, B.eid, B.ew);
    if (seid) { (void)hipMemcpyAsync(seid[0], B.eid, (size_t)n * 8, hipMemcpyDeviceToDevice, st); (void)hipMemcpyAsync(sew[0], B.ew, (size_t)n * 8, hipMemcpyDeviceToDevice, st); }
    moe_ffn<<<n, 256, 0, st>>>(B.hbuf, ob, B.eid, B.ew, m_w1, m_w3, m_w2, ob);
    if (snap) (void)hipMemcpyAsync(snap[1], ob, rowb, hipMemcpyDeviceToDevice, st);
    rmsnorm<<<n, 256, 0, st>>>(ob, D, kv_norm, B.hbuf, D, D);
    gemm<0><<<dim3((KVW + 63) / 64, n / 64), 256, 0, st>>>(B.hbuf, D, kv_w, KVW, B.kvf, KVW, nullptr, nullptr, 0, n, KVW, D);
    headnorm<<<n, 1024, 0, st>>>(B.kvf, KVW, k_norm);
    logf_k<<<n * H / 256, 256, 0, st>>>(B.kvf, kv_b_f, B.lf);
    cumsum_k<<<1, 64, 0, st>>>(B.lf, B.cum, n);
    rmsnorm<<<n, 256, 0, st>>>(ob, D, b_norm, B.hbuf, D, D);
    gemm<0><<<dim3(2 * D / 64, n / 64), 256, 0, st>>>(B.hbuf, D, b_w_qg, 2 * D, B.qg, 2 * D, nullptr, nullptr, 0, n, 2 * D, D);
    headnorm<<<n, 1024, 0, st>>>(B.qg, 2 * D, q_norm);
    attn<<<dim3(n, H), 64, 0, st>>>(B.qg, B.kvf, B.cum, B.ao);
    gemm<2><<<dim3(D / 64, n / 64), 256, 0, st>>>(B.ao, D, b_w_out, D, ob, D, nullptr, ob, D, n, D, D);
    if (snap) (void)hipMemcpyAsync(snap[2], ob, rowb, hipMemcpyDeviceToDevice, st);
    rmsnorm<<<n, 256, 0, st>>>(ob, D, m_norm + D, B.hbuf, D, D);
    route<<<n, 64, 0, st>>>(B.hbuf, m_w_group + D * NG, m_b_group + NG, m_w_expert + D * NE, m_b_expert + NE, B.eid, B.ew);
    if (seid) { (void)hipMemcpyAsync(seid[1], B.eid, (size_t)n * 8, hipMemcpyDeviceToDevice, st); (void)hipMemcpyAsync(sew[1], B.ew, (size_t)n * 8, hipMemcpyDeviceToDevice, st); }
    moe_ffn<<<n, 256, 0, st>>>(B.hbuf, ob, B.eid, B.ew, m_w1 + (size_t)NE * D * DE, m_w3 + (size_t)NE * D * DE, m_w2 + (size_t)NE * DE * D, ob);
    if (snap) (void)hipMemcpyAsync(snap[3], ob, rowb, hipMemcpyDeviceToDevice, st);
}
template <bool BF> __global__ void cmp_k(const void* fast, int ldf, const float* naive, int ldn, int cols, float nscale, float* err, int slot) {
    const int r = blockIdx.x; float d2 = 0.f, n2 = 0.f;
    for (int c = threadIdx.x; c < cols; c += 256) { float f; if (BF) { const unsigned short w = ((const unsigned short*)fast)[(size_t)r * ldf + c]; f = __uint_as_float((unsigned)w << 16); } else f = ((const float*)fast)[(size_t)r * ldf + c];
        const float nv_ = naive[(size_t)r * ldn + c] * nscale; float d = f - nv_; if (!(d == d) || fabsf(d) > 1e30f) d = 1e15f; d2 += d * d; n2 += nv_ * nv_; }
    for (int o = 1; o < 64; o <<= 1) { d2 += __shfl_xor(d2, o); n2 += __shfl_xor(n2, o); }
    if ((threadIdx.x & 63) == 0) { atomicAdd(err + 2 * slot, d2); atomicAdd(err + 2 * slot + 1, n2); }
}
__global__ void cmp_route(const int* LA, const float* LW, const unsigned* cnt  , const int* eid, const float* ew, int tok0, int n, float* err, int slot) {
    const int i = blockIdx.x * 64 + threadIdx.x; if (i >= 2 * n) return; const int e = eid[i]; const int a = 2 * tok0 + i; const int c = (int)cnt[e * 64]; bool ok = false;
    for (int p = 0; p < c && p < LCAP; ++p) if (LA[(size_t)e * LCAP + p] == a) { ok = fabsf(LW[(size_t)e * LCAP + p] - ew[i]) <= 0.02f * fabsf(ew[i]) + 1e-4f; break; }
    atomicAdd(err + 2 * slot, ok ? 0.f : 1.f); atomicAdd(err + 2 * slot + 1, 1.f);
}
__global__ void encode_k(float* out, const float* nout, const float* err, int nslot, float tol) {
    int f = -1; for (int s = 0; s < nslot; ++s) { const float d = err[2 * s], n = err[2 * s + 1]; const float tl = (s == 3 || s == 13) ? 0.03f : tol; if (!(n > 0.f) || !(d <= tl * n)) { f = s; break; } }
    if (f < 0) return; const float k = 1.f + 0.1f * (float)(f + 1);
    for (size_t i = (size_t)blockIdx.x * 256 + threadIdx.x; i < (size_t)T * D; i += (size_t)gridDim.x * 256) out[i] = nout[i] * k;
}
}
#endif
#if DBG
#ifndef DBG_NCHK
#define DBG_NCHK 1024
#endif
#ifndef DBG_CB
#define DBG_CB 0
#endif
static_assert(MK_PER_PHASE == 1, "DBG needs one launch per phase");
namespace nv {
struct Ctx { hipStream_t st; float* out; char* ws; Bufs Bw; float* snap[4]; int* seid[2]; float* sew[2]; float* sgate; float* err; } g;
inline void after(int p) {
    const int n = DBG_NCHK; const size_t tok0 = (size_t)DBG_CB * S; hipStream_t st = g.st; char* ws = g.ws;
    const unsigned short* ZB = (const unsigned short*)(ws + WS_BIG); const unsigned short* GY = (const unsigned short*)(ws + WS_GY); const unsigned short* XB = (const unsigned short*)(ws + WS_XB);
    const unsigned short* KB = ZB; const unsigned short* VB = ZB + (size_t)T * D; const unsigned short* QB = ZB + (size_t)2 * T * D; const unsigned short* GB = ZB + (size_t)3 * T * D;
    const int* LA = (const int*)(ws + WS_LA); const float* LW = (const float*)(ws + WS_LW); const unsigned* cnt = (const unsigned*)(ws + WS_CTL) + CW_CNT;
    if (p == 1) cmp_k<true><<<n, 256, 0, st>>>(ZB + tok0 * ZW, ZW, g.Bw.z, ZW, SW, 1.f, g.err, 0);
    if (p == 2) cmp_k<true><<<n, 256, 0, st>>>(GY + tok0 * SW, SW, g.Bw.gated, SW, SW, 1.f, g.err, 1);
    if (p == 3) cmp_k<false><<<n, 256, 0, st>>>(g.out + tok0 * D, D, g.snap[0], D, D, 1.f, g.err, 2);
    if (p == 4) cmp_route<<<(2 * n + 63) / 64, 64, 0, st>>>(LA, LW, cnt, g.seid[0], g.sew[0], (int)tok0, n, g.err, 3);
    if (p == 7) { cmp_k<false><<<n, 256, 0, st>>>(g.out + tok0 * D, D, g.snap[1], D, D, 1.f, g.err, 4); cmp_k<true><<<n, 256, 0, st>>>(XB + tok0 * D, D, g.snap[1], D, D, 1.f, g.err, 5); }
    if (p == 8) { cmp_k<true><<<n, 256, 0, st>>>(KB + tok0 * D, D, g.Bw.kvf, KVW, D, 1.f, g.err, 6); cmp_k<true><<<n, 256, 0, st>>>(VB + tok0 * D, D, g.Bw.kvf + D, KVW, D, 1.f, g.err, 7);
        cmp_k<true><<<n, 256, 0, st>>>(QB + tok0 * D, D, g.Bw.qg, 2 * D, D, 0.125f * LOG2E, g.err, 8); cmp_k<true><<<n, 256, 0, st>>>(GB + tok0 * D, D, g.sgate, D, D, 1.f, g.err, 9);
        cmp_k<false><<<H, 256, 0, st>>>((const float*)(ws + WS_CUM) + (size_t)DBG_CB * H * S, S, g.Bw.cum, S, n, 1.f, g.err, 10); }
    if (p == 9) cmp_k<true><<<n, 256, 0, st>>>(QB + tok0 * D, D, g.Bw.ao, D, D, 1.f, g.err, 11);
    if (p == 10) cmp_k<false><<<n, 256, 0, st>>>(g.out + tok0 * D, D, g.snap[2], D, D, 1.f, g.err, 12);
    if (p == 11) cmp_route<<<(2 * n + 63) / 64, 64, 0, st>>>(LA, LW, cnt + 32 * 64, g.seid[1], g.sew[1], (int)tok0, n, g.err, 13);
    if (p == 14) cmp_k<false><<<n, 256, 0, st>>>(g.out + tok0 * D, D, g.snap[3], D, D, 1.f, g.err, 14);
}
}
#undef DBG_AFTER_PHASE
#define DBG_AFTER_PHASE(p) nv::after(p)
#define DBG_BEGIN() do { const size_t M_ = 1u << 20; char* db = (char*)d_ws + 400 * M_; nv::g.st = stream; nv::g.out = (float*)d_out; nv::g.ws = (char*)d_ws; nv::g.Bw = nv::carve_small(db); \
    for (int i_ = 0; i_ < 4; ++i_) nv::g.snap[i_] = (float*)(db + (56 + 4 * i_) * M_); nv::g.seid[0] = (int*)(db + 72 * M_); nv::g.seid[1] = (int*)(db + 73 * M_); nv::g.sew[0] = (float*)(db + 74 * M_); nv::g.sew[1] = (float*)(db + 75 * M_); \
    nv::g.sgate = (float*)(db + 76 * M_); float* wout_ = (float*)(db + 80 * M_); nv::g.err = (float*)(db + 84 * M_); (void)hipMemsetAsync(nv::g.err, 0, 4096, stream); \
    nv::run_batch(d_in, (const float*)d_in[0] + (size_t)DBG_CB * S * D, wout_, nv::g.Bw, DBG_NCHK, stream, nv::g.snap, nv::g.seid, nv::g.sew); \
    nv::sigm_k<<<DBG_NCHK * D / 256, 256, 0, stream>>>(nv::g.Bw.qg, nv::g.sgate); } while (0)
#define DBG_END() do { const size_t M_ = 1u << 20; nv::Bufs Bf = nv::carve((char*)d_ws + 2 * M_); float* nout = (float*)((char*)d_ws + 300 * M_); \
    for (int b_ = 0; b_ < NB; ++b_) nv::run_batch(d_in, (const float*)d_in[0] + (size_t)b_ * S * D, nout + (size_t)b_ * S * D, Bf, S, stream, nullptr, nullptr, nullptr); \
    nv::encode_k<<<1024, 256, 0, stream>>>((float*)d_out, nout, nv::g.err, 15, 2e-3f); } while (0)
#else
#define DBG_BEGIN() do { } while (0)
#define DBG_END() do { } while (0)
#endif
extern "C" void kernel_launch(void* const* d_in, const int* in_sizes, int n_in, void* d_out, int out_size, void* d_ws, size_t ws_size, hipStream_t stream) {
    static int grid = 0;
    if (grid == 0) {
        if (n_in != 24 || out_size != T * D || ws_size < WS_END) { grid = -1; return; }
        int dev = 0, cus = 0;
        if (hipGetDevice(&dev) != hipSuccess || hipDeviceGetAttribute(&cus, hipDeviceAttributeMultiprocessorCount, dev) != hipSuccess) { grid = -1; return; }
        if (hipFuncSetAttribute((const void*)fwd, hipFuncAttributeMaxDynamicSharedMemorySize, LDS_BYTES) != hipSuccess) { grid = -1; return; }
        int per_cu = 0; (void)hipOccupancyMaxActiveBlocksPerMultiprocessor(&per_cu, (const void*)fwd, NWAVES * 64, LDS_BYTES); (void)hipGetLastError();
        grid = cus;
    }
    if (grid < 0) return;
    (void)hipMemsetAsync((char*)d_ws + WS_CTL, 0, CTL_ZERO_BYTES, stream);
    DBG_BEGIN();
    Args a{};
    for (int i = 0; i < 24; ++i) a.in[i] = (const float*)d_in[i];
    a.out = (float*)d_out; a.ws = (unsigned char*)d_ws;
#if MK_PER_PHASE
    for (int p = 0; p < NPH; ++p) { a.ph_lo = p; a.ph_hi = p + 1; hipLaunchKernelGGL(fwd, dim3(grid), dim3(NWAVES * 64), LDS_BYTES, stream, a); DBG_AFTER_PHASE(p); }
    DBG_END();
#else
    a.ph_lo = 0; a.ph_hi = NPH; hipLaunchKernelGGL(fwd, dim3(grid), dim3(NWAVES * 64), LDS_BYTES, stream, a);
#endif
}
```

```cpp
#include <hip/hip_bf16.h>
#include <cmath>
#include <hip/hip_runtime.h>

#include <cstdint>


#ifndef DBG
#define DBG 0
#endif
#if DBG
#define MK_PER_PHASE 1
#endif
#ifndef MK_PER_PHASE
#define MK_PER_PHASE 0
#endif
#ifndef NCVT
#define NCVT 51
#endif
#ifndef W13_IN_P6
#define W13_IN_P6 (NE * 128)
#endif
#ifndef TIMEMASK
#define TIMEMASK 0
#endif
#ifndef DBG_AFTER_PHASE
#define DBG_AFTER_PHASE(p) do { } while (0)
#endif

constexpr int D = 1024, NB = 4, S = 4096, T = NB * S, SW = 2048, ZW = 4096, H = 16, HD = 64, NG = 4, EPG = 8, NE = 32, DE = 512, KVW = 2 * D + H;
constexpr int LCAP = 16384;
constexpr int HID_ROWS = 2 * T + NE * 256;
constexpr float EPS = 1e-6f;
constexpr float LOG2E = 1.4426950408889634f;

#define LAS __attribute__((address_space(3)))
#define GAS __attribute__((address_space(1)))

namespace pg8 {
#define PG8_LAS __attribute__((address_space(3)))
typedef unsigned short bf16_t;
typedef short bf16x8 __attribute__((ext_vector_type(8)));
typedef float f32x4 __attribute__((ext_vector_type(4)));
typedef float f32x2 __attribute__((ext_vector_type(2)));
typedef unsigned u32x4 __attribute__((ext_vector_type(4)));
typedef unsigned u32x2 __attribute__((ext_vector_type(2)));
constexpr int BM = 256, BK = 64, HALF = 128, HTB = HALF * BK * 2  , STAGE_BYTES = 8 * HTB, NXCD = 8, WGM = 8;

__host__ __device__ __forceinline__ int lds_byte(int r, int c) { const int st = (r >> 4) * 2 + (c >> 5), rr = r & 15, cc = c & 31, ob = rr * 64 + cc * 2; return st * 1024 + (ob ^ (((ob >> 9) & 1) << 5)); }
__host__ __device__ __forceinline__ void stage_rc(int b, int& R, int& C) { const int st = b / 1024, sb = b % 1024, swz = sb ^ (((sb >> 9) & 1) << 5); R = (st >> 1) * 16 + swz / 64; C = (st & 1) * 32 + (swz % 64) / 2; }
__host__ __device__ __forceinline__ int perm32(int rho) { const int n = rho >> 4, i = rho & 15; return 8 * (i >> 2) + 4 * n + (i & 3); }

struct Unit { int pm, pn, e, slot, hrow0; };

struct DenseOrder {
    int nM, nN, nwg, G, c;
    __device__ void init(int M, int N, int G_, int c_) { nM = M / BM; nN = N / BM; nwg = nM * nN; G = G_; c = c_; }
    __device__ bool next(int i, Unit& u) const {
        const long L = (long)i * G + c; if (L >= nwg) return false;
        int wgid = (int)L; { const int q = nwg / NXCD, r = nwg % NXCD, xcd = wgid % NXCD, off = wgid / NXCD; wgid = (xcd < r ? xcd * (q + 1) : r * (q + 1) + (xcd - r) * q) + off; }
        const int nig = WGM * nN, gid = wgid / nig, fm = gid * WGM, gsz = (nM - fm) < WGM ? (nM - fm) : WGM;
        u.pm = fm + ((wgid % nig) % gsz); u.pn = (wgid % nig) / gsz; u.e = 0; u.slot = 0; u.hrow0 = 0; return true;
    }
    __device__ __forceinline__ int a_row(const Unit& u, int r) const { return u.pm * BM + r; }
    __device__ __forceinline__ int b_row(const Unit& u) const { return u.pn * BM; }
};
template <bool GATHER> struct MoeOrder {
    const PG8_LAS int* mt; const PG8_LAS int* hb; const PG8_LAS int* rowtab; int total, G, c;
    __device__ bool next(int i, Unit& u) const {
        int L = i * G + c; if (L >= total) return false;
        int e = 0;
        for (; e < 31; ++e) { const int ue = 4 * mt[e]; if (L < ue) break; L -= ue; }
        const int m = mt[e]; u.e = e; u.pn = L / m; u.pm = L - u.pn * m; u.slot = i; u.hrow0 = hb[e] + 256 * u.pm; return true;
    }
    __device__ __forceinline__ int a_row(const Unit& u, int r) const { if constexpr (GATHER) return rowtab[u.slot * 256 + r]; else return u.hrow0 + r; }
    __device__ __forceinline__ int b_row(const Unit& u) const { return u.e * 1024 + u.pn * BM; }
};

__device__ __forceinline__ unsigned cvt_pk_bf16(float lo, float hi) { unsigned r; asm volatile("v_cvt_pk_bf16_f32 %0, %1, %2" : "=v"(r) : "v"(lo), "v"(hi)); return r; }
__device__ __forceinline__ u32x4 pack8(f32x4 a, f32x4 b) { u32x4 w; w.x = cvt_pk_bf16(a[0], a[1]); w.y = cvt_pk_bf16(a[2], a[3]); w.z = cvt_pk_bf16(b[0], b[1]); w.w = cvt_pk_bf16(b[2], b[3]); return w; }
__device__ __forceinline__ float bflo(unsigned w) { return __uint_as_float(w << 16); }
__device__ __forceinline__ float bfhi(unsigned w) { return __uint_as_float(w & 0xffff0000u); }
__device__ __forceinline__ float gelu_t(float v) { const float u = v * (1.f + 0.044715f * v * v); return v * __builtin_amdgcn_rcpf(1.f + __builtin_amdgcn_exp2f(-2.302208198f * u)); }
__device__ __forceinline__ f32x4 gelu4(f32x4 v) { return (f32x4){gelu_t(v[0]), gelu_t(v[1]), gelu_t(v[2]), gelu_t(v[3])}; }
__device__ __forceinline__ float sigm(float v) { return __builtin_amdgcn_rcpf(1.f + __builtin_amdgcn_exp2f(-LOG2E * v)); }
__device__ __forceinline__ float sq4(f32x4 v) { return (v[0] * v[0] + v[1] * v[1]) + (v[2] * v[2] + v[3] * v[3]); }

struct EpiIn {
    static constexpr bool PERM = true;
    bf16_t* Z; const float* rstd; const float* bias; float* ssv;
    __device__ __forceinline__ void operator()(const f32x4 (&acc)[2][2][4][2], const Unit& u, int wr, int wc, int fr, int fq) const {
        const int row0 = u.pm * BM + wr * 64 + fr, col0 = u.pn * BM + wc * 32 + 8 * fq;
        f32x4 bv[2][2];
#pragma unroll
        for (int bj = 0; bj < 2; ++bj)
#pragma unroll
            for (int n = 0; n < 2; ++n) bv[bj][n] = *(const f32x4*)(bias + col0 + bj * HALF + 4 * n);
        const bool vhalf = u.pn >= 8;
#pragma unroll
        for (int ai = 0; ai < 2; ++ai)
#pragma unroll
            for (int m = 0; m < 4; ++m) { const int row = row0 + ai * HALF + m * 16; const float rs = rstd[row]; float ss = 0.f;
#pragma unroll
                for (int bj = 0; bj < 2; ++bj) { const f32x4 v0 = gelu4(acc[ai][bj][m][0] * rs + bv[bj][0]), v1 = gelu4(acc[ai][bj][m][1] * rs + bv[bj][1]);
                    ss += sq4(v0) + sq4(v1); *(u32x4*)(Z + (size_t)row * ZW + col0 + bj * HALF) = pack8(v0, v1); }
                if (vhalf) { ss += __shfl_xor(ss, 16); ss += __shfl_xor(ss, 32); if (fq == 0) ssv[(size_t)row * 32 + (u.pn - 8) * 4 + wc] = ss; } }
    }
};
struct EpiRes {
    static constexpr bool PERM = true;
    const float* R; float* O; bf16_t* XB;
    __device__ __forceinline__ void operator()(const f32x4 (&acc)[2][2][4][2], const Unit& u, int wr, int wc, int fr, int fq) const {
        const int row0 = u.pm * BM + wr * 64 + fr, col0 = u.pn * BM + wc * 32 + 8 * fq;
#pragma unroll
        for (int ai = 0; ai < 2; ++ai)
#pragma unroll
            for (int m = 0; m < 4; ++m) { const size_t off = (size_t)(row0 + ai * HALF + m * 16) * D + col0;
#pragma unroll
                for (int bj = 0; bj < 2; ++bj) { const f32x4 r0 = *(const f32x4*)(R + off + bj * HALF), r1 = *(const f32x4*)(R + off + bj * HALF + 4);
                    const f32x4 v0 = acc[ai][bj][m][0] + r0, v1 = acc[ai][bj][m][1] + r1;
                    *(f32x4*)(O + off + bj * HALF) = v0; *(f32x4*)(O + off + bj * HALF + 4) = v1; *(u32x4*)(XB + off + bj * HALF) = pack8(v0, v1); } }
    }
};
struct EpiKVQG {
    static constexpr bool PERM = true;
    bf16_t* KB; const float* rstd; const float* kgain; const float* qgain;
    __device__ __forceinline__ void operator()(const f32x4 (&acc)[2][2][4][2], const Unit& u, int wr, int wc, int fr, int fq) const {
        const int sec = u.pn >> 2, head = (u.pn & 3) * 4 + wc, row0 = u.pm * BM + wr * 64 + fr;
        bf16_t* base = KB + (size_t)sec * T * D + head * HD + 8 * fq;
        const bool nrm = (sec == 0) || (sec == 2); const float* g = (sec == 0) ? kgain : qgain; const float post = (sec == 2) ? 0.125f * LOG2E : 1.f;
        f32x4 gv[2][2];
#pragma unroll
        for (int bj = 0; bj < 2; ++bj)
#pragma unroll
            for (int n = 0; n < 2; ++n) gv[bj][n] = *(const f32x4*)(g + 32 * bj + 8 * fq + 4 * n) * post;
#pragma unroll
        for (int ai = 0; ai < 2; ++ai)
#pragma unroll
            for (int m = 0; m < 4; ++m) { const int row = row0 + ai * HALF + m * 16; const float rs = rstd[row];
                f32x4 v[2][2];
#pragma unroll
                for (int bj = 0; bj < 2; ++bj)
#pragma unroll
                    for (int n = 0; n < 2; ++n) v[bj][n] = acc[ai][bj][m][n] * rs;
                if (nrm) { float ss = (sq4(v[0][0]) + sq4(v[0][1])) + (sq4(v[1][0]) + sq4(v[1][1])); ss += __shfl_xor(ss, 16); ss += __shfl_xor(ss, 32);
                    const float r = __builtin_amdgcn_rsqf(ss * (1.f / 64.f) + EPS);
#pragma unroll
                    for (int bj = 0; bj < 2; ++bj)
#pragma unroll
                        for (int n = 0; n < 2; ++n) v[bj][n] = v[bj][n] * r * gv[bj][n]; }
                else if (sec == 3) {
#pragma unroll
                    for (int bj = 0; bj < 2; ++bj)
#pragma unroll
                        for (int n = 0; n < 2; ++n) v[bj][n] = (f32x4){sigm(v[bj][n][0]), sigm(v[bj][n][1]), sigm(v[bj][n][2]), sigm(v[bj][n][3])}; }
#pragma unroll
                for (int bj = 0; bj < 2; ++bj) *(u32x4*)(base + (size_t)row * D + 32 * bj) = pack8(v[bj][0], v[bj][1]); }
    }
};
struct EpiMoe1 {
    static constexpr bool PERM = true;
    bf16_t* HID; const PG8_LAS float* trs;
    __device__ __forceinline__ void operator()(const f32x4 (&acc)[2][2][4][2], const Unit& u, int wr, int wc, int fr, int fq) const {
#pragma unroll
        for (int ai = 0; ai < 2; ++ai)
#pragma unroll
            for (int m = 0; m < 4; ++m) { const int pos = ai * HALF + wr * 64 + m * 16 + fr; const float rs = trs[u.slot * 256 + pos];
                f32x4 hv[2];
#pragma unroll
                for (int n = 0; n < 2; ++n) { const f32x4 a = acc[ai][0][m][n] * rs, b = acc[ai][1][m][n] * rs;
                    hv[n] = (f32x4){a[0] * sigm(a[0]) * b[0], a[1] * sigm(a[1]) * b[1], a[2] * sigm(a[2]) * b[2], a[3] * sigm(a[3]) * b[3]}; }
                *(u32x4*)(HID + (size_t)(u.hrow0 + pos) * DE + u.pn * HALF + wc * 32 + 8 * fq) = pack8(hv[0], hv[1]); }
    }
};
struct EpiMoe2 {
    static constexpr bool PERM = true;
    bf16_t* Y2; const PG8_LAS int* ta; const PG8_LAS float* tw;
    __device__ __forceinline__ void operator()(const f32x4 (&acc)[2][2][4][2], const Unit& u, int wr, int wc, int fr, int fq) const {
        const int col0 = u.pn * BM + wc * 32 + 8 * fq;
#pragma unroll
        for (int ai = 0; ai < 2; ++ai)
#pragma unroll
            for (int m = 0; m < 4; ++m) { const int pos = ai * HALF + wr * 64 + m * 16 + fr; const int a = ta[u.slot * 256 + pos]; const float w = tw[u.slot * 256 + pos];
                if (a >= 0) {
#pragma unroll
                    for (int bj = 0; bj < 2; ++bj) *(u32x4*)(Y2 + (size_t)a * D + col0 + bj * HALF) = pack8(acc[ai][bj][m][0] * w, acc[ai][bj][m][1] * w); } }
    }
};

template <class Epi, class Sched, bool ALIGN_EPI = false, bool SP2 = false>
__device__ __forceinline__ void gemm_phase(PG8_LAS unsigned char* lds, const bf16_t* Aptr, const bf16_t* Btptr, const int K, const Sched& S, const Epi& E) {
    static_assert(SP2, "only the SP2 loop is kept");
    const int tid = threadIdx.x, wid = __builtin_amdgcn_readfirstlane(tid >> 6), lane = tid & 63, wr = wid >> 2, wc = wid & 3, fr = lane & 15, fq = lane >> 4;
    const int nt = K / BK;
    unsigned voffB[2]; int RA[2], CA[2];
#pragma unroll
    for (int i = 0; i < 2; ++i) { int R, C; stage_rc(tid * 16 + i * 8192, R, C); const int Rb = Epi::PERM ? ((R & ~31) + perm32(R & 31)) : R;
        RA[i] = R; CA[i] = C; voffB[i] = (unsigned)(Rb * K + C) * 2u; }
    unsigned vc[2][2], vn[2][2];
#define PG8_AOFF(dst, unit) do { _Pragma("unroll") for (int _h = 0; _h < 2; ++_h) _Pragma("unroll") for (int _i = 0; _i < 2; ++_i) \
        dst[_h][_i] = (unsigned)(S.a_row(unit, _h * HALF + RA[_i]) * K + CA[_i]) * 2u; } while (0)
    const size_t kstep = (size_t)(BK * 2);
    const size_t hstep = (size_t)HALF * K * 2;
    const unsigned ldsw = (unsigned)wid * 1024u;
    const int aoff = lds_byte(wr * 64 + fr, fq * 8), boff = lds_byte(wc * 32 + fr, fq * 8);
#define PG8_SA(b, h) (((b) * 2 + (h)) * HTB)
#define PG8_SB(b, h) ((4 + (b) * 2 + (h)) * HTB)
#define PG8_STAGE(bufoff, gbase, voff) do { _Pragma("unroll") for (int _i = 0; _i < 2; ++_i) \
        __builtin_amdgcn_global_load_lds((const unsigned*)((const char*)(gbase) + (voff)[_i]), (PG8_LAS unsigned*)(lds + (bufoff) + ldsw + _i * 8192), 16, 0, 0); } while (0)
#define PG8_LDA(dst, b, h) do { _Pragma("unroll") for (int m = 0; m < 4; ++m) _Pragma("unroll") for (int k = 0; k < 2; ++k) dst[m][k] = *(const PG8_LAS bf16x8*)(lds + PG8_SA(b, h) + aoff + m * 2048 + k * 1024); } while (0)
#define PG8_LDB(dst, b, h) do { _Pragma("unroll") for (int n = 0; n < 2; ++n) _Pragma("unroll") for (int k = 0; k < 2; ++k) dst[n][k] = *(const PG8_LAS bf16x8*)(lds + PG8_SB(b, h) + boff + n * 2048 + k * 1024); } while (0)
#define PG8_MMA(ai, bj, At, Bt) do { __builtin_amdgcn_s_setprio(1); _Pragma("unroll") for (int m = 0; m < 4; ++m) _Pragma("unroll") for (int n = 0; n < 2; ++n) _Pragma("unroll") for (int k = 0; k < 2; ++k) \
        acc[ai][bj][m][n] = __builtin_amdgcn_mfma_f32_16x16x32_bf16(Bt[n][k], At[m][k], acc[ai][bj][m][n], 0, 0, 0); __builtin_amdgcn_s_setprio(0); } while (0)
#define PG8_WAIT_V(n) asm volatile("s_waitcnt vmcnt(" #n ")" ::: "memory")
#define PG8_WAIT_L(n) asm volatile("s_waitcnt lgkmcnt(" #n ")" ::: "memory")
#define PG8_BAR __builtin_amdgcn_s_barrier()
#define PG8_SCHED __builtin_amdgcn_sched_barrier(0)
    Unit cur, nxt; int ui = 0;
    if (!S.next(0, cur)) return;
    f32x4 acc[2][2][4][2];
#pragma unroll
    for (int a = 0; a < 2; ++a)
#pragma unroll
        for (int b = 0; b < 2; ++b)
#pragma unroll
            for (int m = 0; m < 4; ++m)
#pragma unroll
                for (int n = 0; n < 2; ++n) acc[a][b][m][n] = (f32x4){0.f, 0.f, 0.f, 0.f};
    bf16x8 At[4][2], B0[2][2], B1[2][2];
    const char* const Ab = (const char*)Aptr; const char* cB = (const char*)Btptr + (size_t)S.b_row(cur) * K * 2;
    PG8_AOFF(vc, cur);
    if constexpr (SP2) {
        PG8_STAGE(PG8_SB(0, 0), cB, voffB); PG8_STAGE(PG8_SB(0, 1), cB + hstep, voffB); PG8_STAGE(PG8_SA(0, 0), Ab, vc[0]); PG8_STAGE(PG8_SA(0, 1), Ab, vc[1]);
        if (wr == 1) PG8_BAR;
        PG8_WAIT_V(2); PG8_BAR;
        PG8_STAGE(PG8_SB(1, 0), cB + kstep, voffB); PG8_STAGE(PG8_SA(1, 0), Ab + kstep, vc[0]); PG8_STAGE(PG8_SB(1, 1), cB + hstep + kstep, voffB);
        PG8_WAIT_V(6); PG8_BAR;
    }
    for (;;) {
        const bool has_next = S.next(ui + 1, nxt);
        const char* nB = has_next ? (const char*)Btptr + (size_t)S.b_row(nxt) * K * 2 : cB;
        if (has_next) { PG8_AOFF(vn, nxt); } else { _Pragma("unroll") for (int _h = 0; _h < 2; ++_h) _Pragma("unroll") for (int _i = 0; _i < 2; ++_i) vn[_h][_i] = vc[_h][_i]; }
        for (int t = 0; t < nt; t += 2) {
            const bool last = (t == nt - 2);
            const char* a1 = Ab + (size_t)(t + 1) * kstep;
            const char* a2 = last ? Ab : Ab + (size_t)(t + 2) * kstep; const char* b2 = last ? nB : cB + (size_t)(t + 2) * kstep;
            const char* a3 = a2 + kstep; const char* b3 = b2 + kstep;
            unsigned v2[2][2];
#pragma unroll
            for (int _h = 0; _h < 2; ++_h)
#pragma unroll
                for (int _i = 0; _i < 2; ++_i) v2[_h][_i] = last ? vn[_h][_i] : vc[_h][_i];
            if constexpr (SP2) {
            PG8_LDB(B0, 0, 0); PG8_LDB(B1, 0, 1); PG8_SCHED; PG8_LDA(At, 0, 0); PG8_STAGE(PG8_SA(1, 1), a1, vc[1]);
            PG8_WAIT_V(8); PG8_WAIT_L(0); PG8_BAR; PG8_MMA(0, 0, At, B0); PG8_MMA(0, 1, At, B1); PG8_BAR; PG8_SCHED;
            PG8_LDA(At, 0, 1); PG8_STAGE(PG8_SB(0, 0), b2, voffB); PG8_STAGE(PG8_SB(0, 1), b2 + hstep, voffB); PG8_STAGE(PG8_SA(0, 0), a2, v2[0]);
            PG8_WAIT_V(8); PG8_WAIT_L(0); PG8_BAR; PG8_MMA(1, 0, At, B0); PG8_MMA(1, 1, At, B1); PG8_BAR; PG8_SCHED;
            PG8_LDB(B0, 1, 0); PG8_LDB(B1, 1, 1); PG8_SCHED; PG8_LDA(At, 1, 0); PG8_STAGE(PG8_SA(0, 1), a2, v2[1]);
            PG8_WAIT_V(8); PG8_WAIT_L(0); PG8_BAR; PG8_MMA(0, 0, At, B0); PG8_MMA(0, 1, At, B1); PG8_BAR; PG8_SCHED;
            PG8_LDA(At, 1, 1); PG8_STAGE(PG8_SB(1, 0), b3, voffB); PG8_STAGE(PG8_SB(1, 1), b3 + hstep, voffB); PG8_STAGE(PG8_SA(1, 0), a3, v2[0]);
            PG8_WAIT_V(8); PG8_WAIT_L(0); PG8_BAR; PG8_MMA(1, 0, At, B0); PG8_MMA(1, 1, At, B1); PG8_BAR; PG8_SCHED;
            }
        }
        if constexpr (ALIGN_EPI) { if (wr == 0) PG8_BAR; }
        E(acc, cur, wr, wc, fr, fq);
        if (!has_next) break;
#pragma unroll
        for (int a = 0; a < 2; ++a)
#pragma unroll
            for (int b = 0; b < 2; ++b)
#pragma unroll
                for (int m = 0; m < 4; ++m)
#pragma unroll
                    for (int n = 0; n < 2; ++n) acc[a][b][m][n] = (f32x4){0.f, 0.f, 0.f, 0.f};
        cur = nxt; cB = nB; ++ui;
#pragma unroll
        for (int _h = 0; _h < 2; ++_h)
#pragma unroll
            for (int _i = 0; _i < 2; ++_i) vc[_h][_i] = vn[_h][_i];
        if constexpr (ALIGN_EPI) { if (wr == 1) PG8_BAR; }
    }
    PG8_WAIT_V(0);
    if constexpr (!ALIGN_EPI) { if (wr == 0) PG8_BAR; }
    PG8_BAR;
#undef PG8_AOFF
#undef PG8_SA
#undef PG8_SB
#undef PG8_STAGE
#undef PG8_LDA
#undef PG8_LDB
#undef PG8_MMA
#undef PG8_WAIT_V
#undef PG8_WAIT_L
#undef PG8_BAR
#undef PG8_SCHED
}
}


namespace attn_body {
using bf16=__hip_bfloat16;
using bf16x8=__attribute__((ext_vector_type(8)))short;
using s16x4=__attribute__((ext_vector_type(4)))short;
using f32x16=__attribute__((ext_vector_type(16)))float;
using u32x4=__attribute__((ext_vector_type(4)))unsigned;
using f32x4v=__attribute__((ext_vector_type(4)))float;
constexpr int BATCH=4,NHEAD=16,SEQ=4096,D=64,DM=NHEAD*D;
constexpr int NW=8,QBLK=32,QB=QBLK*NW,KVBLK=64,NQB=SEQ/QB;
constexpr int ATTN_PITCH=DM, ATTN_UNIT_ROWS=QB;
__device__ __forceinline__ int crow(int r,int hi){return (r&3)+8*(r>>2)+4*hi;}
#define SBAR() __builtin_amdgcn_sched_barrier(0)
__device__ __forceinline__ void cmask(f32x16&p0,f32x16&p1,int jb,int qrel,int hi){
  const float NEG=-INFINITY; int kb=64*jb+4*hi;
  #pragma unroll
  for(int r=0;r<16;++r){int kv=kb+(r&3)+8*(r>>2); if(kv>qrel)p0[r]=NEG; if(kv+32>qrel)p1[r]=NEG;}
}

constexpr int NSLOT=3, SLOTB=8192;
constexpr int LDS_K=0, LDS_V=NSLOT*SLOTB, LDS_WS=2*NSLOT*SLOTB, LDS_OST=LDS_WS+NW*64*4, LDS_CK=LDS_OST+NW*4096, LDS_BYTES=LDS_CK+SEQ*4;
constexpr float C2=0.125f*1.4426950408889634f;
__device__ __forceinline__ void glds16(const void*gsrc,unsigned lds_dst){unsigned keep;
  asm volatile("s_mov_b32 %0, m0\n\ts_mov_b32 m0, %2\n\ts_nop 0\n\tglobal_load_lds_dwordx4 %1, off\n\ts_mov_b32 m0, %0":"=&s"(keep):"v"(gsrc),"s"(lds_dst):"memory");}
__device__ __forceinline__ float max3f(float a,float b,float c){float r;asm("v_max3_f32 %0, %1, %2, %3":"=v"(r):"v"(a),"v"(b),"v"(c));return r;}
__device__ __forceinline__ float max2f(float a,float b){float r;asm("v_max_f32_e32 %0, %1, %2":"=v"(r):"v"(a),"v"(b));return r;}
__device__ __forceinline__ float fadd_s(float a,float b){float r;asm("v_add_f32_e32 %0, %1, %2":"=v"(r):"v"(a),"v"(b));return r;}
__device__ __forceinline__ float fsub_s(float a,float b){float r;asm("v_sub_f32_e32 %0, %1, %2":"=v"(r):"v"(a),"v"(b));return r;}
typedef float f32x2_t __attribute__((ext_vector_type(2))); typedef __bf16 bf16x2_t __attribute__((ext_vector_type(2)));
__device__ __forceinline__ unsigned cvtpk_s(float lo,float hi){f32x2_t v={lo,hi};bf16x2_t b=__builtin_convertvector(v,bf16x2_t);return __builtin_bit_cast(unsigned,b);}
#define WAIT_BAR(N) asm volatile("s_waitcnt vmcnt(" #N ") lgkmcnt(0)\n\ts_barrier":::"memory")

__device__ __forceinline__ void qkt(f32x16&p0,f32x16&p1,const char*Kslot,const bf16x8*qr,int r32,int hi){
  const char*kb=Kslot+hi*1024+r32*16;
  #pragma unroll
  for(int d0=0;d0<4;++d0){
    const bf16x8 b0=*reinterpret_cast<const bf16x8*>(kb+d0*2048);
    const bf16x8 b1=*reinterpret_cast<const bf16x8*>(kb+d0*2048+512);
    p0=__builtin_amdgcn_mfma_f32_32x32x16_bf16(b0,qr[d0],p0,0,0,0);p1=__builtin_amdgcn_mfma_f32_32x32x16_bf16(b1,qr[d0],p1,0,0,0);}
}
typedef __attribute__((address_space(3))) const char* lds_cptr;
typedef short v4i16_t __attribute__((ext_vector_type(4)));
__device__ __forceinline__ void kload8(bf16x8*kf,lds_cptr kp){
  kf[0]=*(const __attribute__((address_space(3))) bf16x8*)(kp);      kf[1]=*(const __attribute__((address_space(3))) bf16x8*)(kp+512);
  kf[2]=*(const __attribute__((address_space(3))) bf16x8*)(kp+2048); kf[3]=*(const __attribute__((address_space(3))) bf16x8*)(kp+2560);
  kf[4]=*(const __attribute__((address_space(3))) bf16x8*)(kp+4096); kf[5]=*(const __attribute__((address_space(3))) bf16x8*)(kp+4608);
  kf[6]=*(const __attribute__((address_space(3))) bf16x8*)(kp+6144); kf[7]=*(const __attribute__((address_space(3))) bf16x8*)(kp+6656);
}
__device__ __forceinline__ void kload2(bf16x8*kf,lds_cptr kp,int j){ kf[2*j]=*(const __attribute__((address_space(3))) bf16x8*)(kp+j*2048); kf[2*j+1]=*(const __attribute__((address_space(3))) bf16x8*)(kp+j*2048+512); }
__device__ __forceinline__ s16x4 vtr(lds_cptr p){ return __builtin_bit_cast(s16x4,__builtin_amdgcn_ds_read_tr16_b64_v4i16((__attribute__((address_space(3))) v4i16_t*)p)); }
__device__ __forceinline__ float rowmax(const f32x16&p0,const f32x16&p1){
  float a=max3f(p0[0],p0[1],p1[0]),b=max3f(p0[2],p0[3],p1[1]);a=max3f(a,p1[2],p1[3]);
  #pragma unroll
  for(int r=4;r<16;r+=4){a=max3f(a,p0[r],p0[r+1]);b=max3f(b,p0[r+2],p0[r+3]);a=max3f(a,p1[r],p1[r+1]);b=max3f(b,p1[r+2],p1[r+3]);}
  const float m=max2f(a,b);
  auto rr=__builtin_amdgcn_permlane32_swap(__float_as_uint(m),__float_as_uint(m),false,false);
  return max2f(__uint_as_float(rr[0]),__uint_as_float(rr[1]));
}
__device__ __forceinline__ void pv(f32x16*o,int vb,bf16x8 pa0,bf16x8 pa1,bf16x8 pa2,bf16x8 pa3){
  #pragma unroll
  for(int d0=0;d0<2;++d0){s16x4 lo[4],hi[4];
    #pragma unroll
    for(int ks=0;ks<4;++ks){
      asm volatile("ds_read_b64_tr_b16 %0,%1 offset:%c2":"=&v"(lo[ks]):"v"(vb),"i"(d0*4096+ks*1024):"memory");
      asm volatile("ds_read_b64_tr_b16 %0,%1 offset:%c2":"=&v"(hi[ks]):"v"(vb),"i"(d0*4096+ks*1024+512):"memory");}
    asm volatile("s_waitcnt lgkmcnt(0)":::"memory");SBAR();
    #define PK(k) (bf16x8){lo[k][0],lo[k][1],lo[k][2],lo[k][3],hi[k][0],hi[k][1],hi[k][2],hi[k][3]}
    o[d0]=__builtin_amdgcn_mfma_f32_32x32x16_bf16(pa0,PK(0),o[d0],0,0,0);
    o[d0]=__builtin_amdgcn_mfma_f32_32x32x16_bf16(pa1,PK(1),o[d0],0,0,0);
    o[d0]=__builtin_amdgcn_mfma_f32_32x32x16_bf16(pa2,PK(2),o[d0],0,0,0);
    o[d0]=__builtin_amdgcn_mfma_f32_32x32x16_bf16(pa3,PK(3),o[d0],0,0,0);
    #undef PK
  }
}

#ifndef ATTN_STORE16
#define ATTN_STORE16(p,v) (*(u32x4*)(p)=(v))
#endif
template<int THRL> __device__ __forceinline__ void attn_unit(int b,int h,int qb,const bf16*Q,const bf16*__restrict__ K,const bf16*__restrict__ V,const bf16*__restrict__ Gt,const float*__restrict__ cum,float TH,bf16*O,char*shm){
  const int tid=threadIdx.x,lane=tid&63,r32=lane&31,hi=lane>>5; const int wid=__builtin_amdgcn_readfirstlane(tid>>6);
  const long rowbase=(long)b*SEQ; const int q0=qb*QB;
  const bf16*Qw=Q+(rowbase+q0+wid*QBLK)*DM+h*D;
  const float*cb=cum+(long)(b*NHEAD+h)*SEQ; const int NTF=(q0+QB)/KVBLK;
  int tstart;
  { const float cq0=cb[q0]; const float ce=cb[(lane<NTF?lane:NTF-1)*KVBLK+KVBLK-1];
    __attribute__((address_space(3))) float*ckw=(__attribute__((address_space(3))) float*)((__attribute__((address_space(3))) char*)shm+LDS_CK);
    #pragma unroll
    for(int j=0;j<2;++j){ const int idx=tid*4+j*2048; if(idx<q0+QB){ const f32x4v v=*reinterpret_cast<const f32x4v*>(cb+idx); const f32x4v w=(cq0-v)*1.4426950408889634f; *(__attribute__((address_space(3))) f32x4v*)(ckw+idx)=w; } }
    const unsigned long long need=__ballot((lane<NTF)&&(ce-cq0<=TH));
    int fs=need?(int)__builtin_ctzll(need):0; if(fs>NTF-4)fs=NTF-4; tstart=__builtin_amdgcn_readfirstlane(fs&~1); }
  const bf16*Kh=K+(rowbase+(long)tstart*KVBLK)*DM+h*D,*Vh=V+(rowbase+(long)tstart*KVBLK)*DM+h*D;
  const __attribute__((address_space(3))) f32x4v* ckp=(const __attribute__((address_space(3))) f32x4v*)((lds_cptr)shm+LDS_CK)+tstart*16+hi;
  const unsigned lds0=(unsigned)(uintptr_t)shm;
  float*wsf=(float*)(shm+LDS_WS)+wid*64;
  const bf16*ksrc=Kh+(long)lane*DM+wid*8;
  const bf16*vsrc=Vh+(long)(16*(wid&3)+(lane>>2))*DM+(wid>>2)*32+(lane&3)*8;
  const unsigned kdst=lds0+LDS_K+wid*1024, vdst=lds0+LDS_V+wid*1024;
  #define DMA_K(t,slot) glds16(ksrc+(long)(t)*KVBLK*DM,(unsigned)__builtin_amdgcn_readfirstlane(kdst+(slot)))
  #define DMA_V(t,slot) glds16(vsrc+(long)(t)*KVBLK*DM,(unsigned)__builtin_amdgcn_readfirstlane(vdst+(slot)))
  const int vb0=(int)(lds0+LDS_V)+((lane>>4)&1)*32+(lane&3)*8+(4*hi+((lane&15)>>2))*64;
  const char*Kbase=shm+LDS_K; bf16x8 kf[8];
  const lds_cptr shm3=(lds_cptr)shm; const lds_cptr kp0=shm3+LDS_K+hi*1024+r32*16; const lds_cptr vp0=shm3+LDS_V+((lane>>4)&1)*32+(lane&3)*8+(4*hi+((lane&15)>>2))*64;
  const int NT=NTF-tstart;
  DMA_K(0,0);DMA_V(0,0);DMA_K(1,SLOTB);
  bf16x8 qr[4];
  #pragma unroll
  for(int d0=0;d0<4;++d0)qr[d0]=*reinterpret_cast<const bf16x8*>(&Qw[(long)r32*DM+d0*16+hi*8]);
  float mhat=0.f,l_reg=0.f;f32x16 o[2];o[0]=f32x16{};o[1]=f32x16{};
  #define CINIT(C0,C1,t) do{ const __attribute__((address_space(3))) f32x4v* cp_=ckp+(t)*16; _Pragma("unroll") for(int g_=0;g_<4;++g_){ const f32x4v b0_=cp_[2*g_],b1_=cp_[2*g_+8]; \
      _Pragma("unroll") for(int i_=0;i_<4;++i_){C0[4*g_+i_]=b0_[i_]-mhat;C1[4*g_+i_]=b1_[i_]-mhat;} } }while(0)
  const int qrel=wid*QBLK+r32;
  #define CMASK(P0,P1,t) do{int jb_=(t)-(NT-4); if(jb_>=0)cmask(P0,P1,jb_,qrel,hi);}while(0)
  bool resc=false;
  #define START(P0,P1) do{ const float rm=rowmax(P0,P1); resc=false; \
    { const float dl=rm; mhat=fadd_s(mhat,dl); \
      _Pragma("unroll") for(int r=0;r<16;++r){P0[r]=fsub_s(P0[r],dl);P1[r]=fsub_s(P1[r],dl);} } \
    _Pragma("unroll") for(int r=0;r<16;++r)P0[r]=__builtin_amdgcn_exp2f(P0[r]); }while(0)
  #define RESC() do{ if(resc){ asm volatile("s_waitcnt lgkmcnt(0)":::"memory"); \
      _Pragma("unroll") for(int d_=0;d_<2;++d_) _Pragma("unroll") for(int r=0;r<16;++r)o[d_][r]*=wsf[crow(r,hi)]; } }while(0)
  f32x16 pA0,pA1,pB0,pB1;
  int sl_prev=0,sl_cur=0,sl_next=SLOTB;
  #define ROT() do{sl_prev=sl_cur;sl_cur=sl_next;sl_next=(sl_next==(NSLOT-1)*SLOTB)?0:sl_next+SLOTB;}while(0)
  DMA_K(2,2*SLOTB);
  WAIT_BAR(3);
  CINIT(pA0,pA1,0); qkt(pA0,pA1,Kbase,qr,r32,hi);asm volatile("s_nop 15\n\ts_nop 7":"+v"(pA0),"+v"(pA1));CMASK(pA0,pA1,0);
  START(pA0,pA1);
  _Pragma("unroll") for(int r=0;r<16;++r)pA1[r]=__builtin_amdgcn_exp2f(pA1[r]);
  WAIT_BAR(0);
  DMA_K(3,0);DMA_V(1,SLOTB);
  ROT();
  kload8(kf,kp0+sl_cur);
  WAIT_BAR(2);
  s16x4 vlo[8],vhi[8]; u32x4 pw0,pw1,pw2,pw3;
  #define PKW(P,B) cvtpk_s(P[B],P[B+1])
  #define PAF(k) __builtin_bit_cast(bf16x8,pw##k)
  #define VFR(i) (bf16x8){vlo[i][0],vlo[i][1],vlo[i][2],vlo[i][3],vhi[i][0],vhi[i][1],vhi[i][2],vhi[i][3]}
  #define PIN(x) asm volatile("":"+v"(x))
  #define MX3(a,b,c) __builtin_fmaxf(__builtin_fmaxf((a),(b)),(c))
  #define GAPA(MF,A0,A1,A2,A3,W0,W1,PW) do{ MF; sacc+=A0; sacc+=A1; sacc+=A2; sacc+=A3; PIN(sacc); W0; W1; PIN(PW); SBAR(); }while(0)
  #define EX(v) __builtin_amdgcn_exp2f(v)
  #define GAPB(MF,X,B) do{ MF; X[B]=EX(X[B]); X[B+1]=EX(X[B+1]); X[B+2]=EX(X[B+2]); X[B+3]=EX(X[B+3]); PIN(X); SBAR(); }while(0)
  #define VRD(i) do{ vlo[i]=vtr(vp_+(((i)>>2)*4096+((i)&3)*1024)); vhi[i]=vtr(vp_+(((i)>>2)*4096+((i)&3)*1024+512)); }while(0)
  #define KRD(G,j) do{ if(G){ kload2(kf,kp0+sl_next,j); SBAR(); } }while(0)
  #define STEP(C0,C1,P0,P1,t,GK,GV,GL) do{ SBAR(); CINIT(C0,C1,t); SBAR(); \
    const lds_cptr vp_=vp0+sl_prev; \
    VRD(0); SBAR(); float sacc=(P0[0]+P0[1]); \
    GAPA(C0=__builtin_amdgcn_mfma_f32_32x32x16_bf16(kf[0],qr[0],C0,0,0,0), P0[2],P0[3],P0[4],P0[5],     pw0[0]=PKW(P0,0), pw0[1]=PKW(P0,2), pw0); \
    VRD(4); SBAR(); GAPA(C1=__builtin_amdgcn_mfma_f32_32x32x16_bf16(kf[1],qr[0],C1,0,0,0), P0[6],P0[7],P0[8],P0[9],     pw0[2]=PKW(P0,4), pw0[3]=PKW(P0,6), pw0); \
    VRD(1); SBAR(); GAPA(C0=__builtin_amdgcn_mfma_f32_32x32x16_bf16(kf[2],qr[1],C0,0,0,0),   P0[10],P0[11],P0[12],P0[13], pw1[0]=PKW(P0,8), pw1[1]=PKW(P0,10), pw1); \
    VRD(5); SBAR(); GAPA(C1=__builtin_amdgcn_mfma_f32_32x32x16_bf16(kf[3],qr[1],C1,0,0,0),   P0[14],P0[15],P1[0],P1[1],   pw1[2]=PKW(P0,12),pw1[3]=PKW(P0,14), pw1); \
    VRD(2); SBAR(); GAPA(C0=__builtin_amdgcn_mfma_f32_32x32x16_bf16(kf[4],qr[2],C0,0,0,0),   P1[2],P1[3],P1[4],P1[5],     pw2[0]=PKW(P1,0), pw2[1]=PKW(P1,2), pw2); \
    VRD(6); SBAR(); GAPA(C1=__builtin_amdgcn_mfma_f32_32x32x16_bf16(kf[5],qr[2],C1,0,0,0),   P1[6],P1[7],P1[8],P1[9],     pw2[2]=PKW(P1,4), pw2[3]=PKW(P1,6), pw2); \
    VRD(3); SBAR(); GAPA(C0=__builtin_amdgcn_mfma_f32_32x32x16_bf16(kf[6],qr[3],C0,0,0,0),   P1[10],P1[11],P1[12],P1[13], pw3[0]=PKW(P1,8), pw3[1]=PKW(P1,10), pw3); \
    VRD(7); SBAR(); GAPA(C1=__builtin_amdgcn_mfma_f32_32x32x16_bf16(kf[7],qr[3],C1,0,0,0),   P1[14],P1[15],0.f,0.f,       pw3[2]=PKW(P1,12),pw3[3]=PKW(P1,14), pw3); \
    l_reg+=sacc; \
    if(GK){DMA_K((t)+3,sl_cur);} if(GV){DMA_V((t)+1,sl_next);} \
    CMASK(C0,C1,t); \
    { float a=MX3(C0[0],C0[1],C1[0]),b=MX3(C0[2],C0[3],C1[1]); a=MX3(a,C1[2],C1[3]); \
      _Pragma("unroll") for(int r=4;r<16;r+=4){a=MX3(a,C0[r],C0[r+1]);b=MX3(b,C0[r+2],C0[r+3]);a=MX3(a,C1[r],C1[r+1]);b=MX3(b,C1[r+2],C1[r+3]);} \
      float rm=__builtin_fmaxf(a,b); { auto rr=__builtin_amdgcn_permlane32_swap(__float_as_uint(rm),__float_as_uint(rm),false,false); rm=__builtin_fmaxf(__uint_as_float(rr[0]),__uint_as_float(rr[1])); } \
      resc=false; \
      if(__builtin_expect(__any(rm>(float)THRL),0)){ const float dl=__builtin_fmaxf(rm,0.f); mhat+=dl; \
        _Pragma("unroll") for(int r=0;r<16;++r){C0[r]-=dl;C1[r]-=dl;} \
        const float f=__builtin_amdgcn_exp2f(-dl); l_reg*=f; if(hi==0)wsf[r32]=f; resc=true; } } \
    SBAR(); \
    GAPB(o[0]=__builtin_amdgcn_mfma_f32_32x32x16_bf16(PAF(0),VFR(0),o[0],0,0,0), C0,0); \
    GAPB(o[1]=__builtin_amdgcn_mfma_f32_32x32x16_bf16(PAF(0),VFR(4),o[1],0,0,0), C0,4); \
    KRD(GL,0); GAPB(o[0]=__builtin_amdgcn_mfma_f32_32x32x16_bf16(PAF(1),VFR(1),o[0],0,0,0), C0,8); \
    KRD(GL,1); GAPB(o[1]=__builtin_amdgcn_mfma_f32_32x32x16_bf16(PAF(1),VFR(5),o[1],0,0,0), C0,12); \
    KRD(GL,2); GAPB(o[0]=__builtin_amdgcn_mfma_f32_32x32x16_bf16(PAF(2),VFR(2),o[0],0,0,0), C1,0); \
    KRD(GL,3); GAPB(o[1]=__builtin_amdgcn_mfma_f32_32x32x16_bf16(PAF(2),VFR(6),o[1],0,0,0), C1,4); \
    GAPB(o[0]=__builtin_amdgcn_mfma_f32_32x32x16_bf16(PAF(3),VFR(3),o[0],0,0,0), C1,8); \
    GAPB(o[1]=__builtin_amdgcn_mfma_f32_32x32x16_bf16(PAF(3),VFR(7),o[1],0,0,0), C1,12); \
    }while(0)
  int t=1;
  #undef CMASK
  #define CMASK(P0,P1,t) do{}while(0)
  for(;t+5<NT;t+=2){
    STEP(pB0,pB1,pA0,pA1,t,true,true,true);     WAIT_BAR(2); RESC(); ROT();
    STEP(pA0,pA1,pB0,pB1,t+1,true,true,true);   WAIT_BAR(2); RESC(); ROT();
  }
  #undef CMASK
  #define CMASK(P0,P1,t) do{int jb_=(t)-(NT-4); if(jb_>=0)cmask(P0,P1,jb_,qrel,hi);}while(0)
  #define ENDW(tt) do{ if((tt)+3<NT){WAIT_BAR(2);} else if((tt)+2<NT){WAIT_BAR(1);} else {WAIT_BAR(0);} }while(0)
  for(;t+1<NT;t+=2){
    STEP(pB0,pB1,pA0,pA1,t,(t+3<NT),(t+1<NT),(t+1<NT));       ENDW(t);   RESC(); ROT();
    STEP(pA0,pA1,pB0,pB1,t+1,(t+4<NT),(t+2<NT),(t+2<NT));     ENDW(t+1); RESC(); ROT();
  }
  STEP(pB0,pB1,pA0,pA1,NT-1,false,false,false); RESC();
  { float sacc=pB0[0]+pB0[1]; _Pragma("unroll") for(int r=2;r<16;++r)sacc+=pB0[r]; _Pragma("unroll") for(int r=0;r<16;++r)sacc+=pB1[r]; l_reg+=sacc;
    pw0=(u32x4){PKW(pB0,0),PKW(pB0,2),PKW(pB0,4),PKW(pB0,6)};pw1=(u32x4){PKW(pB0,8),PKW(pB0,10),PKW(pB0,12),PKW(pB0,14)};pw2=(u32x4){PKW(pB1,0),PKW(pB1,2),PKW(pB1,4),PKW(pB1,6)};pw3=(u32x4){PKW(pB1,8),PKW(pB1,10),PKW(pB1,12),PKW(pB1,14)};
    SBAR(); pv(o,vb0+sl_cur,PAF(0),PAF(1),PAF(2),PAF(3)); }
  #undef PKW
  #undef PAF
  #undef VFR
  #undef PIN
  #undef MX3
  #undef GAPA
  #undef GAPB
  #undef EX
  #undef VRD
  #undef KRD
  #undef STEP
  #undef ENDW
  {auto rr=__builtin_amdgcn_permlane32_swap(__float_as_uint(l_reg),__float_as_uint(l_reg),false,false);l_reg=__uint_as_float(rr[0])+__uint_as_float(rr[1]);}
  if(hi==0)wsf[32+r32]=l_reg;asm volatile("s_waitcnt lgkmcnt(0)":::"memory");
  float rli[16];
  #pragma unroll
  for(int r=0;r<16;++r)rli[r]=__builtin_amdgcn_rcpf(wsf[32+crow(r,hi)]);
  bf16*Ow=O+(rowbase+q0+wid*QBLK)*DM+h*D;
  { bf16*stg=(bf16*)(shm+LDS_OST)+wid*2048;
    #pragma unroll
    for(int r=0;r<16;++r){const int orow=crow(r,hi);
      #pragma unroll
      for(int d0=0;d0<2;++d0)stg[orow*64+d0*32+r32]=__float2bfloat16(o[d0][r]*rli[r]);}
    asm volatile("s_waitcnt lgkmcnt(0)":::"memory");
    const bf16*Gw=Gt+(rowbase+q0+wid*QBLK)*DM+h*D;
    #pragma unroll
    for(int i=0;i<4;++i){const int row=i*8+(lane>>3),ch=lane&7; u32x4 v=*(const u32x4*)(stg+row*64+ch*8); const u32x4 gg=*(const u32x4*)(Gw+(long)row*DM+ch*8);
      #pragma unroll
      for(int e_=0;e_<4;++e_){ const float lo=__uint_as_float(v[e_]<<16)*__uint_as_float(gg[e_]<<16), hi_=__uint_as_float(v[e_]&0xffff0000u)*__uint_as_float(gg[e_]&0xffff0000u); v[e_]=cvtpk_s(lo,hi_); }
      ATTN_STORE16(Ow+(long)row*DM+ch*8,v);} }
  asm volatile("s_waitcnt lgkmcnt(0)\n\ts_barrier":::"memory");
  #undef CINIT
  #undef DMA_K
  #undef DMA_V
  #undef CMASK
  #undef START
  #undef RESC
  #undef ROT
}
constexpr int ATTN_LDS_BYTES=LDS_BYTES;
struct AttnTensors { const bf16* Q; const bf16* K; const bf16* V; const bf16* G; const float* cum; float TH; bf16* O; };
struct AttnUnit { int bh; int qb; };
struct StaticOrder {
  int vcu, grid;
  __device__ __forceinline__ explicit StaticOrder(int grid_,int block):vcu((grid_%8==0)?(block%8)*(grid_/8)+block/8:block),grid(grid_){}
  __device__ __forceinline__ bool next(int i,AttnUnit&u)const{
    if(grid==256){ if(i>=4)return false; const int s=vcu&3; u.bh=vcu>>2; u.qb=(i==0)?s:(i==1)?7-s:(i==2)?8+s:15-s; return true; }
    const int L=i*grid+vcu; if(L>=BATCH*NHEAD*NQB)return false; u.bh=L/NQB; u.qb=L%NQB; return true; }
};
template<class Sched,int THRL=8> __device__ __forceinline__ void attn_phase(char*lds,const AttnTensors&T,const Sched&S){
  AttnUnit u;
  for(int i=0;S.next(i,u);++i){ attn_unit<THRL>(u.bh/NHEAD,u.bh%NHEAD,u.qb,T.Q,T.K,T.V,T.G,T.cum,T.TH,T.O,lds); }
}
#undef SBAR
#undef WAIT_BAR
}

constexpr size_t MiB = 1u << 20;
constexpr size_t WS_CTL = 0, CTL_ZERO_BYTES = 1 * MiB;
constexpr size_t WS_RSTD = 1 * MiB;
constexpr size_t WS_SSV = 2 * MiB;
constexpr size_t WS_LF = 4 * MiB, WS_CUM = 5 * MiB;
constexpr size_t WS_LA = 6 * MiB, WS_LW = 8 * MiB, WS_LR = 10 * MiB;
constexpr size_t WS_WRT = 12 * MiB;
constexpr size_t WS_WFT = 12 * MiB + 512 * 1024;
constexpr size_t WS_WSM = 13 * MiB;
constexpr size_t WS_WIN = 16 * MiB, WS_WOUT = 24 * MiB, WS_WKVQG = 28 * MiB, WS_WO = 36 * MiB;
constexpr size_t WS_W13 = 40 * MiB, WS_W2 = 104 * MiB;
constexpr size_t WS_XB = 136 * MiB;
constexpr size_t WS_BIG = 168 * MiB;
constexpr size_t WS_GY = 296 * MiB;
constexpr size_t WS_HID = 360 * MiB;
constexpr size_t WS_END = 400 * MiB;
static_assert(WS_HID + (size_t)HID_ROWS * DE * 2 <= WS_END, "ws map");
constexpr int CW_TMO = 0, CW_CODE = 1, CW_BAR = 4096, CW_CNT = 8192;

constexpr int RING_OFF = 0, RING_BYTES = 131072;
constexpr int LDSCTL_OFF = RING_BYTES, MISC_OFF = LDSCTL_OFF + 320;
constexpr int TAB_OFF = LDSCTL_OFF + 512;
constexpr int TABA_OFF = TAB_OFF + 512, TABF_OFF = TABA_OFF + 4096;
constexpr int LDS_BYTES = 147456;
static_assert(TABF_OFF + 4096 <= LDS_BYTES, "LDS map");
constexpr int NWAVES = 8;
constexpr int NPH = 15;

typedef unsigned short bf16;
typedef unsigned v4u __attribute__((ext_vector_type(4)));
typedef unsigned v2u __attribute__((ext_vector_type(2)));
typedef float f32x4 __attribute__((ext_vector_type(4)));
typedef short bf16x8 __attribute__((ext_vector_type(8)));
typedef GAS unsigned gu32;
#define RLX_AGENT __ATOMIC_RELAXED, __HIP_MEMORY_SCOPE_AGENT
#define LDS_WAIT() asm volatile("s_waitcnt lgkmcnt(0)" ::: "memory")
#define VM_WAIT() asm volatile("s_waitcnt vmcnt(0)" ::: "memory")
__device__ __forceinline__ unsigned pk2(float lo, float hi) { return pg8::cvt_pk_bf16(lo, hi); }
__device__ __forceinline__ float bf_lo(unsigned w) { return __uint_as_float(w << 16); }
__device__ __forceinline__ float bf_hi(unsigned w) { return __uint_as_float(w & 0xffff0000u); }

#define XB_TMO      128
#define XB_XCNT(j)  (256  + 64 * (j))
#define XB_XSUB(j)  (1280 + 64 * (j))
#define XB_XGEN(j)  (2304 + 64 * (j))
#define XB_TOP      3328
#define XB_TOPGEN   3392
#define XCD_BAR_WORDS 3456
#define XB_SPIN_CAP (1u << 18)

__device__ __forceinline__ unsigned xb_ld(unsigned* p)              { return __hip_atomic_load(p, __ATOMIC_RELAXED, __HIP_MEMORY_SCOPE_AGENT); }
__device__ __forceinline__ unsigned xb_add(unsigned* p, unsigned v) { return __hip_atomic_fetch_add(p, v, __ATOMIC_RELAXED, __HIP_MEMORY_SCOPE_AGENT); }
__device__ __forceinline__ unsigned xb_xcc_id() { return (unsigned)__builtin_amdgcn_s_getreg((3 << 11) | 20) & 0xFu; }
#define XB_SPIN(cond, bar) do { unsigned _sp = 0; while (cond) { __builtin_amdgcn_s_sleep(1); \
    if ((++_sp & 255u) == 0u) { if (xb_ld(&(bar)[XB_TMO])) break; if (_sp > XB_SPIN_CAP) { atomicAdd(&(bar)[XB_TMO], 1u); break; } } } } while (0)

struct XcdBarrier {
    unsigned* bar; unsigned x;
    volatile LAS unsigned* st;
};

__device__ __forceinline__ XcdBarrier xcd_barrier_post(unsigned* bar, volatile LAS unsigned* st) {
    XcdBarrier b; b.bar = bar; b.x = xb_xcc_id(); b.st = st;
    if (threadIdx.x == 0) (void)xb_add(&bar[XB_XCNT(b.x)], 1u);
    return b;
}
__device__ __forceinline__ void xcd_barrier_complete(unsigned* bar, unsigned x, unsigned& nloc, unsigned& nx) {
    const unsigned G = gridDim.x * gridDim.y * gridDim.z;
    unsigned sum, cnt, mine, sp = 0u;
    for (;;) {
        sum = 0u; cnt = 0u; mine = 0u;
#pragma unroll
        for (unsigned j = 0; j < 16; ++j) { const unsigned c = xb_ld(&bar[XB_XCNT(j)]); sum += c; cnt += (c > 0u) ? 1u : 0u; mine = (j == x) ? c : mine; }
        if (sum == G) break;
        __builtin_amdgcn_s_sleep(1);
        if ((++sp & 255u) == 0u) { if (xb_ld(&bar[XB_TMO])) break; if (sp > XB_SPIN_CAP) { atomicAdd(&bar[XB_TMO], 1u); break; } }
    }
    nloc = mine > 0u ? mine : 1u; nx = cnt > 0u ? cnt : 1u;
}

__device__ __forceinline__ void xcd_barrier(const XcdBarrier& b) {
    asm volatile("s_waitcnt vmcnt(0)" ::: "memory");
    __syncthreads();
    if (threadIdx.x == 0) {
        unsigned* bar = b.bar;
        __builtin_amdgcn_s_waitcnt(0);
        unsigned nloc = b.st[0], nx = b.st[1];
        if (nloc == 0u) { xcd_barrier_complete(bar, b.x, nloc, nx); b.st[0] = nloc; b.st[1] = nx; }
        const unsigned old = xb_add(&bar[XB_XSUB(b.x)], 1u);
        const unsigned gen = old / nloc;
        if (old + 1u == (gen + 1u) * nloc) {
            __builtin_amdgcn_fence(__ATOMIC_RELEASE, "agent");
            asm volatile("s_waitcnt vmcnt(0)" ::: "memory");
            const unsigned og = xb_add(&bar[XB_TOP], 1u);
            const unsigned tg = og / nx;
            if (og + 1u == (tg + 1u) * nx) xb_add(&bar[XB_TOPGEN], 1u);
            else XB_SPIN(xb_ld(&bar[XB_TOPGEN]) == tg, bar);
            __builtin_amdgcn_fence(__ATOMIC_ACQUIRE, "agent");
            xb_add(&bar[XB_XGEN(b.x)], 1u);
            asm volatile("s_waitcnt vmcnt(0)" ::: "memory");
        } else {
            XB_SPIN(xb_ld(&bar[XB_XGEN(b.x)]) == gen, bar);
            __builtin_amdgcn_fence(__ATOMIC_ACQUIRE, "agent");
            asm volatile("s_waitcnt vmcnt(0)" ::: "memory");
        }
    }
    __syncthreads();
}

struct Frame {
    LAS unsigned char* lds;
    volatile LAS unsigned* MISC;
    gu32* ctl;
    int tid, lane, wave, vcu, G;
    const float* in[24]; float* out; unsigned char* ws;
};
__device__ __forceinline__ float wave_sum(float v) {
#pragma unroll
    for (int o = 1; o < 64; o <<= 1) v += __shfl_xor(v, o);
    return v;
}
struct CvtItem { const float* src; const float* gain; bf16* dst; int ldw, K, dbase, dhi; };
__device__ __forceinline__ CvtItem cvt_item(const float* W, int ldw, int K, const float* gain, bf16* WT, int dbase, int dhi, int k0, int n0) {
    CvtItem c; c.src = W + (size_t)k0 * ldw + n0; c.gain = gain ? gain + k0 : nullptr; c.dst = WT + k0; c.ldw = ldw; c.K = K; c.dbase = dbase; c.dhi = dhi; return c; }
struct CvtRegs { f32x4 v[16]; float gl; };
__device__ __forceinline__ void cvt_load(const CvtItem& c, CvtRegs& r, int lane) {
    const int q = lane >> 4, cc = lane & 15; const float* src = c.src + (size_t)(2 * q) * c.ldw + 4 * cc;
#pragma unroll
    for (int i = 0; i < 16; ++i) r.v[i] = __builtin_nontemporal_load((const f32x4*)(src + (size_t)(8 * (i >> 1) + (i & 1)) * c.ldw));
    r.gl = c.gain ? c.gain[lane] : 1.f;
}
__device__ __forceinline__ void cvt_finish(const CvtItem& c, CvtRegs& r, LAS unsigned* scr, int lane) {
    const int q = lane >> 4, cc = lane & 15;
    if (c.gain) {
#pragma unroll
        for (int i = 0; i < 16; ++i) { const float g = __shfl(r.gl, 8 * (i >> 1) + 2 * q + (i & 1)); r.v[i] = r.v[i] * g; } }
#pragma unroll
    for (int m = 0; m < 8; ++m)
#pragma unroll
        for (int j = 0; j < 4; ++j) scr[(4 * cc + j) * 33 + 4 * m + q] = pk2(r.v[2 * m][j], r.v[2 * m + 1][j]);
    LDS_WAIT(); asm volatile("" ::: "memory");
    const int ch = lane & 7;
#pragma unroll
    for (int rr = 0; rr < 8; ++rr) { const int n = (lane >> 3) + 8 * rr; const LAS unsigned* sp = scr + n * 33 + 4 * ch;
        v4u o; o.x = sp[0]; o.y = sp[1]; o.z = sp[2]; o.w = sp[3];
        __builtin_nontemporal_store(o, (GAS v4u*)(c.dst + (size_t)(c.dbase + (n & 31) + (n >> 5) * c.dhi) * c.K + 8 * ch)); }
    LDS_WAIT(); asm volatile("" ::: "memory");
}
__device__ __forceinline__ void tr_item64(const float* W, int ldw, int K, const float* gain, bf16* WT, int dbase, int dhi, LAS unsigned* scr, int k0, int n0, int lane) {
    const CvtItem c = cvt_item(W, ldw, K, gain, WT, dbase, dhi, k0, n0); CvtRegs r; cvt_load(c, r, lane); cvt_finish(c, r, scr, lane);
}
__device__ __forceinline__ int hp_base(int a) { return (a & ~255) + ((a & 255) >> 6) * 32; }
__device__ __forceinline__ CvtItem w13_item(Frame& F, int layer, int it) {
    const float* w1 = F.in[21] + (size_t)layer * NE * D * DE; const float* w3 = F.in[22] + (size_t)layer * NE * D * DE; const float* mg = F.in[16] + layer * D; bf16* W13 = (bf16*)(F.ws + WS_W13);
    const int e = it >> 8, which = (it >> 7) & 1, sub = it & 127, kb = sub >> 3, nb = sub & 7, c0 = 64 * nb; const int dst = e * 1024 + 256 * (c0 >> 7) + (c0 & 127) + which * 128;
    return cvt_item((which ? w3 : w1) + (size_t)e * D * DE, DE, D, mg, W13, dst, 32, 64 * kb, c0);
}
__device__ __forceinline__ CvtItem w2_item(Frame& F, int layer, int it) {
    const float* w2 = F.in[23] + (size_t)layer * NE * DE * D; bf16* W2 = (bf16*)(F.ws + WS_W2);
    const int e = it >> 7, sub = it & 127, kb = sub >> 4, nb = sub & 15; return cvt_item(w2 + (size_t)e * DE * D, D, DE, nullptr, W2, e * 1024 + 64 * nb, 32, 64 * kb, 64 * nb);
}
__device__ __forceinline__ void cvt_w13_item(Frame& F, int layer, int it, LAS unsigned* scr) { const CvtItem c = w13_item(F, layer, it); CvtRegs r; cvt_load(c, r, F.lane); cvt_finish(c, r, scr, F.lane); }
__device__ __forceinline__ void cvt_w2_item(Frame& F, int layer, int it, LAS unsigned* scr) { const CvtItem c = w2_item(F, layer, it); CvtRegs r; cvt_load(c, r, F.lane); cvt_finish(c, r, scr, F.lane); }
template <bool W2> __device__ __forceinline__ void cvt_slice(Frame& F, int layer, int lo, int hi, int w, int nw) {
    LAS unsigned* scr = (LAS unsigned*)(F.lds + RING_OFF + F.wave * 16384);
    int it = lo + w; if (it >= hi) return;
    CvtItem c = W2 ? w2_item(F, layer, it) : w13_item(F, layer, it); CvtRegs r; cvt_load(c, r, F.lane);
    for (;;) { const int nx = it + nw; const bool more = nx < hi; CvtItem cn = c; CvtRegs rn;
        if (more) { cn = W2 ? w2_item(F, layer, nx) : w13_item(F, layer, nx); cvt_load(cn, rn, F.lane); }
        cvt_finish(c, r, scr, F.lane);
        if (!more) break;
        c = cn; r = rn; it = nx; }
}
__device__ __forceinline__ void p0_prologue(Frame& F) {
    LAS unsigned* scr = (LAS unsigned*)(F.lds + RING_OFF + F.wave * 16384);
    const int gw = F.vcu * NWAVES + F.wave, NGW = F.G * NWAVES;
    bf16* WIN = (bf16*)(F.ws + WS_WIN); bf16* WOUT = (bf16*)(F.ws + WS_WOUT); bf16* WKVQG = (bf16*)(F.ws + WS_WKVQG); bf16* WO = (bf16*)(F.ws + WS_WO);
    { float* rstd = (float*)(F.ws + WS_RSTD); bf16* XB = (bf16*)(F.ws + WS_XB);
      for (int m = 2 * gw; m < T; m += 2 * NGW) { const GAS f32x4* xr = (const GAS f32x4*)(F.in[0] + (size_t)m * D) + F.lane; f32x4 v[8]; float s0 = 0.f, s1 = 0.f;
#pragma unroll
          for (int j = 0; j < 8; ++j) v[j] = xr[64 * j];
#pragma unroll
          for (int j = 0; j < 4; ++j) { s0 += pg8::sq4(v[j]); s1 += pg8::sq4(v[4 + j]); }
          s0 = wave_sum(s0); s1 = wave_sum(s1); if (F.lane == 0) { rstd[m] = 1.0f / sqrtf(s0 * (1.f / D) + EPS); rstd[m + 1] = 1.0f / sqrtf(s1 * (1.f / D) + EPS); }
          GAS v2u* o8 = (GAS v2u*)(XB + (size_t)m * D) + F.lane;
#pragma unroll
          for (int j = 0; j < 8; ++j) o8[64 * j] = (v2u){pk2(v[j][0], v[j][1]), pk2(v[j][2], v[j][3])}; } }
    constexpr int I1 = 16 * 64, I2 = 32 * 16, I3 = 16 * 16, IDENSE = I1 + I2 + 5 * I3;
    const int nitems = IDENSE + NE * 256 + (F.G == 256 && NCVT > 0 ? 0 : NE * 128);
    for (int it = gw; it < nitems; it += NGW) {
        int r = it;
        if (r >= IDENSE + NE * 256) { cvt_w2_item(F, 0, r - IDENSE - NE * 256, scr); continue; }
        if (r >= IDENSE) { cvt_w13_item(F, 0, r - IDENSE, scr); continue; }
        if (r < I1) { const int kb = r >> 6, nb = r & 63; tr_item64(F.in[2], ZW, D, F.in[1], WIN, 64 * nb, 32, scr, 64 * kb, 64 * nb, F.lane); continue; } r -= I1;
        if (r < I2) { const int kb = r >> 4, nb = r & 15; tr_item64(F.in[7], D, SW, nullptr, WOUT, 64 * nb, 32, scr, 64 * kb, 64 * nb, F.lane); continue; } r -= I2;
        const int job = r / I3, rr = r % I3, kb = rr >> 4, nb = rr & 15;
        if (job == 0) tr_item64(F.in[9], KVW, D, F.in[8], WKVQG, hp_base(64 * nb), 128, scr, 64 * kb, 64 * nb, F.lane);
        else if (job == 1) tr_item64(F.in[9], KVW, D, F.in[8], WKVQG, 1024 + hp_base(64 * nb), 128, scr, 64 * kb, 1024 + 64 * nb, F.lane);
        else if (job == 2) tr_item64(F.in[13], 2 * D, D, F.in[12], WKVQG, 2048 + hp_base(64 * nb), 128, scr, 64 * kb, 64 * nb, F.lane);
        else if (job == 3) tr_item64(F.in[13], 2 * D, D, F.in[12], WKVQG, 3072 + hp_base(64 * nb), 128, scr, 64 * kb, 1024 + 64 * nb, F.lane);
        else tr_item64(F.in[15], D, D, nullptr, WO, 64 * nb, 32, scr, 64 * kb, 64 * nb, F.lane);
    }
    { const int gt = F.vcu * (NWAVES * 64) + F.tid, NGT = F.G * NWAVES * 64;
      float* WFT = (float*)(F.ws + WS_WFT); float* WRT = (float*)(F.ws + WS_WRT); bf16* WSM = (bf16*)(F.ws + WS_WSM);
      for (int i = gt; i < H * D; i += NGT) { const int h = i >> 10, k = i & 1023; WFT[i] = F.in[9][(size_t)k * KVW + 2 * D + h] * F.in[8][k]; }
      for (int i = gt; i < 2 * 48 * D; i += NGT) { const int l = i / (48 * D), j = (i >> 10) % 48, k = i & 1023; const float g = F.in[16][l * D + k];
          float v = 0.f; if (j < 32) v = F.in[19][((size_t)l * D + k) * NE + j] * g; else if (j < 36) v = F.in[17][((size_t)l * D + k) * NG + (j - 32)] * g; WRT[i] = v; }
      for (int i = gt; i < 8 * 128 * 128; i += NGT) { const int t = (i >> 7) & 127, s = i & 127; const float v = (t < 64 && s >= 64) ? 0.f : F.in[5][i]; WSM[i] = (bf16)(pk2(v, 0.f) & 0xffffu); } }
}
constexpr int SG_WSTR = 272, SG_VSTR = 524;
constexpr int SG_WOFF = 0, SG_VOFF = 128 * SG_WSTR, SG_ROFF = SG_VOFF + 128 * SG_VSTR;
static_assert(SG_ROFF + 512 <= RING_BYTES, "sgu LDS");
__device__ __forceinline__ void sgu_phase(Frame& F) {
    const bf16* Z = (const bf16*)(F.ws + WS_BIG); bf16* GY = (bf16*)(F.ws + WS_GY); const bf16* WSM = (const bf16*)(F.ws + WS_WSM); const float* ssv = (const float*)(F.ws + WS_SSV);
    const float* gvn = F.in[4]; const float* bs = F.in[6];
    LAS unsigned char* L = F.lds + RING_OFF; LAS float* rs = (LAS float*)(L + SG_ROFF);
    const int tid = F.tid, lane = F.lane, w = F.wave, n15 = lane & 15, kq = lane >> 4;
    int gloaded = -1;
    for (int u = F.vcu; u < (T / 128) * 8; u += F.G) {
        const int g = u & 7, nb = u >> 3;
        if (g != gloaded) {
#pragma unroll
            for (int j = 0; j < 4; ++j) { const int idx = tid + 512 * j, row = idx >> 4, cc = idx & 15;
                *(LAS v4u*)(L + SG_WOFF + row * SG_WSTR + cc * 16) = *(const v4u*)(WSM + (size_t)g * 16384 + row * 128 + cc * 8); }
            gloaded = g; }
        if (tid < 128) { const float* p = ssv + (size_t)(nb * 128 + tid) * 32; float s = 0.f;
#pragma unroll
            for (int j = 0; j < 8; ++j) { const f32x4 v = *(const f32x4*)(p + 4 * j); s += (v[0] + v[1]) + (v[2] + v[3]); }
            rs[tid] = 1.0f / sqrtf(s * (1.f / SW) + EPS); }
        __syncthreads();
#pragma unroll
        for (int j = 0; j < 8; ++j) { const int idx = tid + 512 * j, s = idx >> 5, cc = idx & 31;
            const v4u raw = *(const v4u*)(Z + (size_t)(nb * 128 + s) * ZW + SW + 256 * g + 8 * cc); const float r = rs[s];
            LAS unsigned* dst = (LAS unsigned*)(L + SG_VOFF + s * SG_VSTR + cc * 16);
            dst[0] = pk2(bf_lo(raw.x) * r, bf_hi(raw.x) * r); dst[1] = pk2(bf_lo(raw.y) * r, bf_hi(raw.y) * r); dst[2] = pk2(bf_lo(raw.z) * r, bf_hi(raw.z) * r); dst[3] = pk2(bf_lo(raw.w) * r, bf_hi(raw.w) * r); }
        __syncthreads();
        f32x4 acc[8][2];
#pragma unroll
        for (int mt = 0; mt < 8; ++mt) { acc[mt][0] = (f32x4){0.f, 0.f, 0.f, 0.f}; acc[mt][1] = (f32x4){0.f, 0.f, 0.f, 0.f}; }
#pragma unroll
        for (int ks = 0; ks < 4; ++ks) {
            bf16x8 vf[2];
#pragma unroll
            for (int nt = 0; nt < 2; ++nt) { const LAS unsigned short* vp = (const LAS unsigned short*)(L + SG_VOFF) + (32 * ks + 8 * kq) * (SG_VSTR / 2) + 32 * w + 16 * nt + n15;
#pragma unroll
                for (int j = 0; j < 8; ++j) vf[nt][j] = (short)vp[j * (SG_VSTR / 2)]; }
#pragma unroll
            for (int mt = 0; mt < 8; ++mt) if (mt >= 4 || ks < 2) {
                const bf16x8 wf = *(const LAS bf16x8*)(L + SG_WOFF + (16 * mt + n15) * SG_WSTR + (32 * ks + 8 * kq) * 2);
                acc[mt][0] = __builtin_amdgcn_mfma_f32_16x16x32_bf16(vf[0], wf, acc[mt][0], 0, 0, 0); acc[mt][1] = __builtin_amdgcn_mfma_f32_16x16x32_bf16(vf[1], wf, acc[mt][1], 0, 0, 0); }
        }
#pragma unroll
        for (int mt = 0; mt < 8; ++mt) { const int t = 16 * mt + n15; const float bst = bs[g * 128 + t]; const size_t row = (size_t)nb * 128 + t;
#pragma unroll
            for (int nt = 0; nt < 2; ++nt) { const int c0 = 256 * g + 32 * w + 16 * nt + 4 * kq; const f32x4 gv = *(const f32x4*)(gvn + c0); const v2u uu = *(const v2u*)(Z + row * ZW + c0);
                const f32x4 a = acc[mt][nt];
                const float o0 = bf_lo(uu.x) * (gv[0] * a[0] + bst), o1 = bf_hi(uu.x) * (gv[1] * a[1] + bst), o2 = bf_lo(uu.y) * (gv[2] * a[2] + bst), o3 = bf_hi(uu.y) * (gv[3] * a[3] + bst);
                *(v2u*)(GY + row * SW + c0) = (v2u){pk2(o0, o1), pk2(o2, o3)}; } }
        __syncthreads();
    }
}
__device__ __forceinline__ void route_phase(Frame& F, int layer) {
    const float* X = F.out; const float* WRT = (const float*)(F.ws + WS_WRT) + (size_t)layer * 48 * D;
    const float* bg = F.in[18] + layer * NG; const float* be = F.in[20] + layer * NE;
    int* LA = (int*)(F.ws + WS_LA); float* LW = (float*)(F.ws + WS_LW); float* LR = (float*)(F.ws + WS_LR);
    LAS unsigned char* L = F.lds + RING_OFF;
    LAS float* lg = (LAS float*)L + F.wave * (16 * 48);
    LAS int* lcnt = (LAS int*)(L + 16384); LAS int* lbase = lcnt + 32; LAS int* sel_e = lcnt + 64; LAS int* sel_rk = lcnt + 192; LAS float* sel_w = (LAS float*)(lcnt + 320); LAS float* sel_r = (LAS float*)(lcnt + 448);
    const int tid = F.tid, lane = F.lane, m = lane & 15, kq = lane >> 4;
    for (int grp = F.vcu; grp < T / 64; grp += F.G) {
        if (tid < 32) lcnt[tid] = 0;
        __syncthreads();
        const int tile = F.wave & 3, kh = F.wave >> 2, r0 = grp * 64 + tile * 16;
        f32x4 a0 = (f32x4){0.f, 0.f, 0.f, 0.f}, a1 = a0, a2 = a0; float ss = 0.f;
        {   const float* xr = X + (size_t)(r0 + m) * D + kh * 512 + 4 * kq; const float* w0 = WRT + (size_t)m * D + kh * 512 + 4 * kq;
#pragma unroll 8
            for (int J = 0; J < 32; ++J) { const f32x4 xv = *(const f32x4*)(xr + 16 * J); const f32x4 b0 = *(const f32x4*)(w0 + 16 * J), b1 = *(const f32x4*)(w0 + 16 * D + 16 * J), b2 = *(const f32x4*)(w0 + 32 * D + 16 * J);
                ss += pg8::sq4(xv);
#pragma unroll
                for (int i = 0; i < 4; ++i) { a0 = __builtin_amdgcn_mfma_f32_16x16x4f32(xv[i], b0[i], a0, 0, 0, 0); a1 = __builtin_amdgcn_mfma_f32_16x16x4f32(xv[i], b1[i], a1, 0, 0, 0); a2 = __builtin_amdgcn_mfma_f32_16x16x4f32(xv[i], b2[i], a2, 0, 0, 0); } }
            ss += __shfl_xor(ss, 16); ss += __shfl_xor(ss, 32);
            LAS f32x4* px = (LAS f32x4*)(L + 32768) + tile * 192 + lane; LAS float* ps = (LAS float*)(L + 32768 + 12288) + tile * 64 + lane;
            if (kh == 1) { px[0] = a0; px[64] = a1; px[128] = a2; ps[0] = ss; }
            __syncthreads();
            if (kh == 0) { a0 = a0 + px[0]; a1 = a1 + px[64]; a2 = a2 + px[128]; ss += ps[0]; }
        }
        if (F.wave < 4) {
            const float rstd = 1.0f / sqrtf(ss * (1.f / D) + EPS);
#pragma unroll
            for (int i = 0; i < 4; ++i) { const float rr = __shfl(rstd, 4 * kq + i); LAS float* p = lg + (4 * kq + i) * 48 + m; p[0] = a0[i] * rr; p[16] = a1[i] * rr; p[32] = a2[i] * rr; }
            LDS_WAIT(); asm volatile("" ::: "memory");
            if (lane < 16) {
                const LAS float* lr = lg + lane * 48;
                float gl[4];
#pragma unroll
                for (int j = 0; j < 4; ++j) gl[j] = lr[32 + j] + bg[j];
                int gs = 0; float gm = gl[0];
#pragma unroll
                for (int j = 1; j < 4; ++j) if (gl[j] > gm) { gm = gl[j]; gs = j; }
                float gsum = 0.f;
#pragma unroll
                for (int j = 0; j < 4; ++j) gsum += __expf(gl[j] - gm);
                const float gw = 1.f / gsum;
                float el[8];
#pragma unroll
                for (int j = 0; j < 8; ++j) el[j] = lr[gs * 8 + j] + be[gs * 8 + j];
                int i0 = 0; float v0 = el[0];
#pragma unroll
                for (int j = 1; j < 8; ++j) if (el[j] > v0) { v0 = el[j]; i0 = j; }
                int i1 = -1; float v1 = -INFINITY;
#pragma unroll
                for (int j = 0; j < 8; ++j) if (j != i0 && el[j] > v1) { v1 = el[j]; i1 = j; }
                const float p1 = __expf(v1 - v0), w0_ = 1.f / (1.f + p1), w1_ = p1 * w0_;
                const int e0 = gs * 8 + i0, e1 = gs * 8 + i1, q = F.wave * 16 + lane;
                sel_e[2 * q] = e0; sel_e[2 * q + 1] = e1; sel_w[2 * q] = gw * w0_; sel_w[2 * q + 1] = gw * w1_; sel_r[q] = rstd;
                sel_rk[2 * q] = __hip_atomic_fetch_add(lcnt + e0, 1, __ATOMIC_RELAXED, __HIP_MEMORY_SCOPE_WORKGROUP);
                sel_rk[2 * q + 1] = __hip_atomic_fetch_add(lcnt + e1, 1, __ATOMIC_RELAXED, __HIP_MEMORY_SCOPE_WORKGROUP);
            }
        }
        __syncthreads();
        if (tid < 32) { const int c = lcnt[tid]; lbase[tid] = c ? (int)__hip_atomic_fetch_add(F.ctl + CW_CNT + (layer * 32 + tid) * 64, (unsigned)c, RLX_AGENT) : 0; }
        __syncthreads();
        if (tid < 128) { const int e = sel_e[tid]; const int pos = lbase[e] + sel_rk[tid]; const size_t o = (size_t)e * LCAP + pos;
            LA[o] = 2 * (grp * 64 + (tid >> 1)) + (tid & 1); LW[o] = sel_w[tid]; LR[o] = sel_r[tid >> 1]; }
        __syncthreads();
    }
}
template <bool G1> __device__ __forceinline__ int moe_setup(Frame& F, int layer, int Geff, int ceff) {
    LAS int* mt = (LAS int*)(F.lds + TAB_OFF); LAS int* hb = mt + 32; LAS int* cl = mt + 64; LAS int* tot = mt + 96;
    LAS int* tabA = (LAS int*)(F.lds + TABA_OFF); LAS float* tabF = (LAS float*)(F.lds + TABF_OFF);
    const int* LA = (const int*)(F.ws + WS_LA); const float* LW = (const float*)(F.ws + WS_LW); const float* LR = (const float*)(F.ws + WS_LR);
    if (F.tid < 32) { const int c = (int)__hip_atomic_load(F.ctl + CW_CNT + (layer * 32 + F.tid) * 64, RLX_AGENT); cl[F.tid] = c; mt[F.tid] = (c + 255) >> 8; }
    __syncthreads();
    if (F.tid == 0) { int s = 0; for (int e = 0; e < 32; ++e) { hb[e] = 256 * s; s += mt[e]; } tot[0] = 4 * s; }
    __syncthreads();
    const int total = tot[0];
    for (int idx = F.tid; idx < 4 * 256; idx += NWAVES * 64) {
        const int slot = idx >> 8, r = idx & 255; int Lx = slot * Geff + ceff; int a = G1 ? 0 : -1; float f = 0.f;
        if (Lx < total) { int e = 0; for (; e < 31; ++e) { const int ue = 4 * mt[e]; if (Lx < ue) break; Lx -= ue; }
            const int m = mt[e], pn = Lx / m, pm = Lx - pn * m, pos = 256 * pm + r;
            if (pos < cl[e]) { const size_t o = (size_t)e * LCAP + pos; const int av = LA[o]; a = G1 ? (av >> 1) : av; f = G1 ? LR[o] : LW[o]; } }
        tabA[idx] = a; tabF[idx] = f;
    }
    __syncthreads();
    return total;
}
__device__ __forceinline__ void combine0_phase(Frame& F) {
    const bf16* Y2 = (const bf16*)(F.ws + WS_GY); bf16* XB = (bf16*)(F.ws + WS_XB); float* rstd = (float*)(F.ws + WS_RSTD); float* LF = (float*)(F.ws + WS_LF);
    const float* WFT = (const float*)(F.ws + WS_WFT); const float* bfv = F.in[10];
    LAS float* rsl = (LAS float*)(F.lds + RING_OFF); LAS f32x4* cf = (LAS f32x4*)(F.lds + RING_OFF + 1024);
    const int lane = F.lane, m = lane & 15, kq = lane >> 4, tile = F.wave & 3, kh = F.wave >> 2;
    for (int grp = F.vcu; grp < T / 64; grp += F.G) {
#pragma unroll 2
        for (int i = 0; i < 8; ++i) { const int row = grp * 64 + F.wave * 8 + i;
            GAS f32x4* xr = (GAS f32x4*)(F.out + (size_t)row * D) + lane; const GAS v2u* ya = (const GAS v2u*)(Y2 + (size_t)(2 * row) * D) + lane; const GAS v2u* yb = ya + D / 4; GAS v2u* xb = (GAS v2u*)(XB + (size_t)row * D) + lane;
            float ss = 0.f;
#pragma unroll
            for (int j = 0; j < 4; ++j) { const f32x4 xv = xr[64 * j]; const v2u a = ya[64 * j], b = yb[64 * j];
                const f32x4 x2 = (f32x4){xv[0] + bf_lo(a.x) + bf_lo(b.x), xv[1] + bf_hi(a.x) + bf_hi(b.x), xv[2] + bf_lo(a.y) + bf_lo(b.y), xv[3] + bf_hi(a.y) + bf_hi(b.y)};
                xr[64 * j] = x2; xb[64 * j] = (v2u){pk2(x2[0], x2[1]), pk2(x2[2], x2[3])}; ss += pg8::sq4(x2); }
            ss = wave_sum(ss); const float rs = 1.0f / sqrtf(ss * (1.f / D) + EPS);
            if (lane == 0) { rstd[row] = rs; rsl[F.wave * 8 + i] = rs; } }
        VM_WAIT(); __syncthreads();
        const int r0 = grp * 64 + tile * 16;
        const float* xr = F.out + (size_t)(r0 + m) * D + kh * 512 + 4 * kq; const float* wf = WFT + (size_t)m * D + kh * 512 + 4 * kq;
        f32x4 fa = (f32x4){0.f, 0.f, 0.f, 0.f};
#pragma unroll 8
        for (int J = 0; J < 32; ++J) { const f32x4 xv = *(const f32x4*)(xr + 16 * J); const f32x4 wv = *(const f32x4*)(wf + 16 * J);
#pragma unroll
            for (int i = 0; i < 4; ++i) fa = __builtin_amdgcn_mfma_f32_16x16x4f32(xv[i], wv[i], fa, 0, 0, 0); }
        if (kh == 1) cf[tile * 64 + lane] = fa;
        __syncthreads();
        if (kh == 0) { fa = fa + cf[tile * 64 + lane];
            f32x4 o; const float bb = bfv[m];
#pragma unroll
            for (int i = 0; i < 4; ++i) { const float f = fa[i] * rsl[tile * 16 + 4 * kq + i] + bb; o[i] = fminf(f, 0.f) - log1pf(__expf(-fabsf(f))); }
            const int b = r0 / S, t0 = r0 % S; *(f32x4*)(LF + ((size_t)(b * H + m)) * S + t0 + 4 * kq) = o; }
        __syncthreads();
    }
}
__device__ __forceinline__ void cumsum_seq(Frame& F, int seq) {
    const float* lf = (const float*)(F.ws + WS_LF) + (size_t)seq * S; float* cum = (float*)(F.ws + WS_CUM) + (size_t)seq * S;
    LAS float* wt = (LAS float*)(F.lds + RING_OFF);
    const f32x4 a = *(const f32x4*)(lf + 8 * F.tid), b = *(const f32x4*)(lf + 8 * F.tid + 4);
    float p[8]; p[0] = a[0]; p[1] = p[0] + a[1]; p[2] = p[1] + a[2]; p[3] = p[2] + a[3]; p[4] = p[3] + b[0]; p[5] = p[4] + b[1]; p[6] = p[5] + b[2]; p[7] = p[6] + b[3];
    float incl = p[7];
#pragma unroll
    for (int o = 1; o < 64; o <<= 1) { const float v = __shfl_up(incl, o); if (F.lane >= o) incl += v; }
    if (F.lane == 63) wt[F.wave] = incl;
    __syncthreads();
    float base = incl - p[7];
    for (int w = 0; w < F.wave; ++w) base += wt[w];
    *(f32x4*)(cum + 8 * F.tid) = (f32x4){p[0] + base, p[1] + base, p[2] + base, p[3] + base}; *(f32x4*)(cum + 8 * F.tid + 4) = (f32x4){p[4] + base, p[5] + base, p[6] + base, p[7] + base};
    __syncthreads();
}
__device__ __forceinline__ void final_phase(Frame& F) {
    const bf16* Y2 = (const bf16*)(F.ws + WS_GY); const int gw = F.vcu * NWAVES + F.wave, NGW = F.G * NWAVES;
    for (int m = gw; m < T; m += NGW) { GAS f32x4* xr = (GAS f32x4*)(F.out + (size_t)m * D) + F.lane; const GAS v2u* ya = (const GAS v2u*)(Y2 + (size_t)(2 * m) * D) + F.lane; const GAS v2u* yb = ya + D / 4;
#pragma unroll
        for (int j = 0; j < 4; ++j) { const f32x4 xv = xr[64 * j]; const v2u a = ya[64 * j], b = yb[64 * j];
            xr[64 * j] = (f32x4){xv[0] + bf_lo(a.x) + bf_lo(b.x), xv[1] + bf_hi(a.x) + bf_hi(b.x), xv[2] + bf_lo(a.y) + bf_lo(b.y), xv[3] + bf_hi(a.y) + bf_hi(b.y)}; } }
}

struct Args { const float* in[24]; float* out; unsigned char* ws; int ph_lo, ph_hi; };
__global__ void __launch_bounds__(NWAVES * 64, 2) fwd(Args args) {
    extern __shared__ __attribute__((aligned(16))) unsigned char lds[];
    Frame F;
    F.lds = (LAS unsigned char*)lds; F.MISC = (volatile LAS unsigned*)(F.lds + MISC_OFF);
    F.tid = threadIdx.x; F.lane = F.tid & 63; F.wave = __builtin_amdgcn_readfirstlane(F.tid >> 6);
    F.G = gridDim.x; { const int bx = blockIdx.x; F.vcu = (F.G % 8 == 0) ? (bx % 8) * (F.G / 8) + bx / 8 : bx; }
    F.ws = args.ws; F.ctl = (gu32*)(args.ws + WS_CTL); F.out = args.out;
#pragma unroll
    for (int i = 0; i < 24; ++i) F.in[i] = args.in[i];
    for (int u = F.tid; u < (TAB_OFF - LDSCTL_OFF) / 4; u += NWAVES * 64) ((LAS unsigned*)(F.lds + LDSCTL_OFF))[u] = 0u;
    __syncthreads();
#if MK_PER_PHASE
#define GRID_BAR() do { } while (0)
#else
    XcdBarrier bar = xcd_barrier_post((unsigned*)(F.ctl + CW_BAR), F.MISC + 8);
#define GRID_BAR() xcd_barrier(bar)
#endif
    const int lo = args.ph_lo, hi = args.ph_hi;
#define IN(k) (lo <= (k) && (k) < hi)
#define SEAM(k) do { if (IN(k) && IN((k) + 1)) GRID_BAR(); } while (0)
#define PH_BEGIN(k) const unsigned long long t0_##k = ((TIMEMASK >> (k)) & 1) ? __builtin_amdgcn_s_memrealtime() : 0ull
#define PH_END(k) do { if ((TIMEMASK >> (k)) & 1) { const unsigned long long t1_ = __builtin_amdgcn_s_memrealtime(); while (__builtin_amdgcn_s_memrealtime() - t1_ < t1_ - t0_##k) __builtin_amdgcn_s_sleep(8); } } while (0)
    bf16* XB = (bf16*)(F.ws + WS_XB); float* RSTD = (float*)(F.ws + WS_RSTD);
    bf16* ZB = (bf16*)(F.ws + WS_BIG); bf16* GY = (bf16*)(F.ws + WS_GY); bf16* HID = (bf16*)(F.ws + WS_HID);
    bf16* KB = ZB; bf16* VB = ZB + (size_t)T * D; bf16* QB = ZB + (size_t)2 * T * D; bf16* GB = ZB + (size_t)3 * T * D;
    LAS int* mt = (LAS int*)(F.lds + TAB_OFF); LAS int* hb = mt + 32; LAS int* tabA = (LAS int*)(F.lds + TABA_OFF); LAS float* tabF = (LAS float*)(F.lds + TABF_OFF);

    PH_BEGIN(0); if (IN(0)) { p0_prologue(F); } PH_END(0); SEAM(0);
    const bool split = (F.G == 256) && (NCVT > 0); const int NGEMM = split ? 256 - NCVT : F.G; const bool cvt_role = split && (int)blockIdx.x >= NGEMM;
    const int cw = ((int)blockIdx.x - NGEMM) * NWAVES + F.wave, cnw = NCVT * NWAVES;
    const int gw_all = F.vcu * NWAVES + F.wave, nw_all = F.G * NWAVES;
    PH_BEGIN(1); if (IN(1)) { pg8::DenseOrder So; So.init(T, ZW, F.G, (int)blockIdx.x); pg8::EpiIn E{ZB, RSTD, F.in[3], (float*)(F.ws + WS_SSV)};
        pg8::gemm_phase<pg8::EpiIn, pg8::DenseOrder, true, true>(F.lds + RING_OFF, XB, (const bf16*)(F.ws + WS_WIN), D, So, E); } PH_END(1); SEAM(1);
    PH_BEGIN(2); if (IN(2)) { sgu_phase(F); } PH_END(2); SEAM(2);
    PH_BEGIN(3); if (IN(3)) { pg8::DenseOrder So; So.init(T, D, F.G, (int)blockIdx.x); pg8::EpiRes E{F.in[0], F.out, XB};
        pg8::gemm_phase<pg8::EpiRes, pg8::DenseOrder, true, true>(F.lds + RING_OFF, GY, (const bf16*)(F.ws + WS_WOUT), SW, So, E); } PH_END(3); SEAM(3);
    PH_BEGIN(4); if (IN(4)) { route_phase(F, 0); } PH_END(4); SEAM(4);
    PH_BEGIN(5); if (IN(5)) { if (cvt_role) cvt_slice<true>(F, 0, 0, NE * 128, cw, cnw); else {
        const int total = moe_setup<true>(F, 0, NGEMM, (int)blockIdx.x); pg8::MoeOrder<true> So{mt, hb, tabA, total, NGEMM, (int)blockIdx.x}; pg8::EpiMoe1 E{HID, tabF};
        pg8::gemm_phase<pg8::EpiMoe1, pg8::MoeOrder<true>, true, true>(F.lds + RING_OFF, XB, (const bf16*)(F.ws + WS_W13), D, So, E); } } PH_END(5); SEAM(5);
    PH_BEGIN(6); if (IN(6)) { if (cvt_role) cvt_slice<false>(F, 1, 0, W13_IN_P6, cw, cnw); else {
        const int total = moe_setup<false>(F, 0, NGEMM, (int)blockIdx.x); pg8::MoeOrder<false> So{mt, hb, tabA, total, NGEMM, (int)blockIdx.x}; pg8::EpiMoe2 E{GY, tabA, tabF};
        pg8::gemm_phase<pg8::EpiMoe2, pg8::MoeOrder<false>, true, true>(F.lds + RING_OFF, HID, (const bf16*)(F.ws + WS_W2), DE, So, E); } } PH_END(6); SEAM(6);
    PH_BEGIN(7); if (IN(7)) { combine0_phase(F); cvt_slice<false>(F, 1, split ? W13_IN_P6 : 0, NE * 256, gw_all, nw_all); if (!split) cvt_slice<true>(F, 1, 0, NE * 128, gw_all, nw_all); } PH_END(7); SEAM(7);
    PH_BEGIN(8); if (IN(8)) { for (int sq = F.vcu; sq < NB * H; sq += F.G) cumsum_seq(F, sq);
        pg8::DenseOrder So; So.init(T, 4 * D, F.G, (int)blockIdx.x); pg8::EpiKVQG E{KB, RSTD, F.in[11], F.in[14]};
        pg8::gemm_phase<pg8::EpiKVQG, pg8::DenseOrder, true, true>(F.lds + RING_OFF, XB, (const bf16*)(F.ws + WS_WKVQG), D, So, E); } PH_END(8); SEAM(8);
    PH_BEGIN(9); if (IN(9)) { float gq = fabsf(F.in[14][F.lane]), gk = fabsf(F.in[11][F.lane]);
#pragma unroll
        for (int o = 1; o < 64; o <<= 1) { gq = fmaxf(gq, __shfl_xor(gq, o)); gk = fmaxf(gk, __shfl_xor(gk, o)); }
        const float TH = 104.f + 16.f * gq * gk * 1.02f + 4.f;
        const attn_body::AttnTensors AT{(const attn_body::bf16*)QB, (const attn_body::bf16*)KB, (const attn_body::bf16*)VB, (const attn_body::bf16*)GB, (const float*)(F.ws + WS_CUM), TH, (attn_body::bf16*)QB};
        const attn_body::StaticOrder Sa((int)F.G, (int)blockIdx.x);
        attn_body::attn_phase<attn_body::StaticOrder>((char*)lds + RING_OFF, AT, Sa); } PH_END(9); SEAM(9);
    PH_BEGIN(10); if (IN(10)) { pg8::DenseOrder So; So.init(T, D, F.G, (int)blockIdx.x); pg8::EpiRes E{F.out, F.out, XB};
        pg8::gemm_phase<pg8::EpiRes, pg8::DenseOrder, true, true>(F.lds + RING_OFF, QB, (const bf16*)(F.ws + WS_WO), D, So, E); } PH_END(10); SEAM(10);
    PH_BEGIN(11); if (IN(11)) { route_phase(F, 1); } PH_END(11); SEAM(11);
    PH_BEGIN(12); if (IN(12)) { if (cvt_role) cvt_slice<true>(F, 1, 0, NE * 128, cw, cnw); else {
        const int total = moe_setup<true>(F, 1, NGEMM, (int)blockIdx.x); pg8::MoeOrder<true> So{mt, hb, tabA, total, NGEMM, (int)blockIdx.x}; pg8::EpiMoe1 E{HID, tabF};
        pg8::gemm_phase<pg8::EpiMoe1, pg8::MoeOrder<true>, true, true>(F.lds + RING_OFF, XB, (const bf16*)(F.ws + WS_W13), D, So, E); } } PH_END(12); SEAM(12);
    PH_BEGIN(13); if (IN(13)) { const int total = moe_setup<false>(F, 1, F.G, F.vcu); pg8::MoeOrder<false> So{mt, hb, tabA, total, F.G, F.vcu}; pg8::EpiMoe2 E{GY, tabA, tabF};
        pg8::gemm_phase<pg8::EpiMoe2, pg8::MoeOrder<false>, true, true>(F.lds + RING_OFF, HID, (const bf16*)(F.ws + WS_W2), DE, So, E); } PH_END(13); SEAM(13);
    PH_BEGIN(14); if (IN(14)) { final_phase(F); } PH_END(14);
#undef IN
#undef SEAM
}


#if DBG
namespace nv {

__global__ void rmsnorm(const float* x, int ldx, const float* g, float* y, int ldy, int W) {
    const int r = blockIdx.x; const float* xr = x + (size_t)r * ldx;
    float s = 0.f; for (int c = threadIdx.x; c < W; c += 256) { const float v = xr[c]; s += v * v; }
    __shared__ float red[256]; red[threadIdx.x] = s; __syncthreads();
    for (int o = 128; o > 0; o >>= 1) { if ((int)threadIdx.x < o) red[threadIdx.x] += red[threadIdx.x + o]; __syncthreads(); }
    const float rs = rsqrtf(red[0] / (float)W + EPS);
    for (int c = threadIdx.x; c < W; c += 256) y[(size_t)r * ldy + c] = xr[c] * rs * g[c];
}
__global__ void headnorm(float* x, int ld, const float* g) {
    const int r = blockIdx.x, c = threadIdx.x; float v = x[(size_t)r * ld + c]; float s = v * v;
    for (int o = 1; o < 64; o <<= 1) s += __shfl_xor(s, o);
    x[(size_t)r * ld + c] = v * rsqrtf(s / 64.f + EPS) * g[c & 63];
}
__device__ __forceinline__ float gelu_tanh(float v) { return 0.5f * v * (1.f + tanhf(0.7978845608028654f * (v + 0.044715f * v * v * v))); }
template <int MODE> __global__ void gemm(const float* A, int lda, const float* Bm, int ldb, float* C, int ldc, const float* bias, const float* R, int ldr, int M, int N, int K) {
    __shared__ float As[16][68], Bs[16][68];
    const int tx = threadIdx.x % 16, ty = threadIdx.x / 16, m0 = blockIdx.y * 64, n0 = blockIdx.x * 64;
    float acc[4][4] = {};
    for (int k0 = 0; k0 < K; k0 += 16) {
        for (int i = threadIdx.x; i < 1024; i += 256) { const int m = i / 16, k = i % 16; As[k][m] = A[(size_t)(m0 + m) * lda + k0 + k]; }
        for (int i = threadIdx.x; i < 1024; i += 256) { const int k = i / 64, n = i % 64; Bs[k][n] = (n0 + n < N) ? Bm[(size_t)(k0 + k) * ldb + n0 + n] : 0.f; }
        __syncthreads();
#pragma unroll
        for (int k = 0; k < 16; ++k) {
            float a[4], b[4];
#pragma unroll
            for (int i = 0; i < 4; ++i) { a[i] = As[k][ty * 4 + i]; b[i] = Bs[k][tx * 4 + i]; }
#pragma unroll
            for (int i = 0; i < 4; ++i)
#pragma unroll
                for (int j = 0; j < 4; ++j) acc[i][j] += a[i] * b[j];
        }
        __syncthreads();
    }
    for (int i = 0; i < 4; ++i) for (int j = 0; j < 4; ++j) {
        const int m = m0 + ty * 4 + i, n = n0 + tx * 4 + j; if (n >= N) continue;
        float v = acc[i][j]; if (bias) v += bias[n]; if (MODE == 1) v = gelu_tanh(v); if (MODE == 2) v += R[(size_t)m * ldr + n];
        C[(size_t)m * ldc + n] = v;
    }
}
__global__ void sgu(const float* z, const float* w_s, const float* b_s, float* gated) {
    const int c = blockIdx.x * 256 + threadIdx.x, t = blockIdx.y, g = c / 256, blk = t / 128, tt = t % 128;
    const float* W = w_s + ((size_t)g * 128 + tt) * 128; float acc = 0.f; const int smax = (tt < 64) ? 64 : 128;
    for (int s = 0; s < smax; ++s) acc += W[s] * z[(size_t)(blk * 128 + s) * ZW + SW + c];
    gated[(size_t)t * SW + c] = z[(size_t)t * ZW + c] * (acc + b_s[g * 128 + tt]);
}
__global__ void route(const float* xn, const float* wg, const float* bg, const float* we, const float* be, int* eid, float* ew) {
    const int t = blockIdx.x, l = threadIdx.x; __shared__ float part[64][37]; __shared__ float lg[36];
    float a[36]; for (int j = 0; j < 36; ++j) a[j] = 0.f;
    for (int k = l; k < D; k += 64) { const float xv = xn[(size_t)t * D + k];
        for (int j = 0; j < 32; ++j) a[j] += xv * we[(size_t)k * NE + j];
        for (int j = 0; j < 4; ++j) a[32 + j] += xv * wg[(size_t)k * NG + j]; }
    for (int j = 0; j < 36; ++j) part[l][j] = a[j];
    __syncthreads();
    if (l < 36) { float s = 0.f; for (int i = 0; i < 64; ++i) s += part[i][l]; lg[l] = s + (l < 32 ? be[l] : bg[l - 32]); }
    __syncthreads();
    if (l == 0) {
        int gs = 0; float gm = lg[32]; for (int j = 1; j < 4; ++j) if (lg[32 + j] > gm) { gm = lg[32 + j]; gs = j; }
        float gsum = 0.f; for (int j = 0; j < 4; ++j) gsum += expf(lg[32 + j] - gm); const float gw = 1.f / gsum;
        const float* el = lg + gs * EPG; int i0 = 0; for (int j = 1; j < EPG; ++j) if (el[j] > el[i0]) i0 = j;
        int i1 = (i0 == 0) ? 1 : 0; for (int j = 0; j < EPG; ++j) if (j != i0 && el[j] > el[i1]) i1 = j;
        const float p1 = expf(el[i1] - el[i0]); const float w0 = 1.f / (1.f + p1), w1 = p1 / (1.f + p1);
        eid[2 * t] = gs * EPG + i0; eid[2 * t + 1] = gs * EPG + i1; ew[2 * t] = gw * w0; ew[2 * t + 1] = gw * w1;
    }
}
__global__ void moe_ffn(const float* xn, const float* xres, const int* eid, const float* ew, const float* w1, const float* w3, const float* w2, float* out) {
    __shared__ float xs[1024], hs[512]; const int t = blockIdx.x, tid = threadIdx.x;
    for (int i = tid; i < D; i += 256) xs[i] = xn[(size_t)t * D + i];
    float o[4] = {0.f, 0.f, 0.f, 0.f}; __syncthreads();
    for (int k = 0; k < 2; ++k) { const int e = eid[2 * t + k]; const float w = ew[2 * t + k];
        const float* W1 = w1 + (size_t)e * D * DE; const float* W3 = w3 + (size_t)e * D * DE; const float* W2 = w2 + (size_t)e * DE * D;
        for (int j = tid; j < DE; j += 256) { float a = 0.f, b = 0.f; for (int kk = 0; kk < D; ++kk) { a += xs[kk] * W1[(size_t)kk * DE + j]; b += xs[kk] * W3[(size_t)kk * DE + j]; }
            hs[j] = a / (1.f + expf(-a)) * b; }
        __syncthreads();
        for (int i = 0; i < 4; ++i) { const int n = tid + 256 * i; float y = 0.f; for (int j = 0; j < DE; ++j) y += hs[j] * W2[(size_t)j * D + n]; o[i] += w * y; }
        __syncthreads(); }
    for (int i = 0; i < 4; ++i) { const int n = tid + 256 * i; out[(size_t)t * D + n] = xres[(size_t)t * D + n] + o[i]; }
}
__global__ void logf_k(const float* kvf, const float* bf, float* lf) {
    const int i = blockIdx.x * 256 + threadIdx.x, t = i / H, h = i % H; const float f = kvf[(size_t)t * KVW + 2 * D + h] + bf[h];
    lf[i] = fminf(f, 0.f) - log1pf(expf(-fabsf(f)));
}
__global__ void cumsum_k(const float* lf, float* cum, int n) {
    const int h = threadIdx.x; if (h >= H) return; double s = 0.0; for (int t = 0; t < n; ++t) { s += (double)lf[t * H + h]; cum[h * S + t] = (float)s; }
}
__global__ void attn(const float* qg, const float* kvf, const float* cum, float* ao) {
    const int t = blockIdx.x, h = blockIdx.y, d = threadIdx.x; const float qd = qg[(size_t)t * 2 * D + h * HD + d]; const float ct = cum[h * S + t];
    float m = -INFINITY, l = 0.f, acc = 0.f;
    for (int s = 0; s <= t; ++s) { float p = qd * kvf[(size_t)s * KVW + h * HD + d];
        for (int o = 1; o < 64; o <<= 1) p += __shfl_xor(p, o);
        const float sc = p * 0.125f + ct - cum[h * S + s]; const float mn = fmaxf(m, sc), f = expf(m - mn), e = expf(sc - mn);
        l = l * f + e; acc = acc * f + e * kvf[(size_t)s * KVW + D + h * HD + d]; m = mn; }
    const float gt = qg[(size_t)t * 2 * D + D + h * HD + d];
    ao[(size_t)t * D + h * HD + d] = acc / l / (1.f + expf(-gt));
}
}
namespace nv {
struct Bufs { float *hbuf, *z, *gated, *kvf, *qg, *ao, *lf, *cum; int* eid; float* ew; };
__host__ inline Bufs carve(char* base) { const size_t M = 1u << 20; Bufs b; b.hbuf = (float*)(base); b.z = (float*)(base + 16 * M); b.gated = (float*)(base + 80 * M); b.kvf = (float*)(base + 112 * M);
    b.qg = (float*)(base + 146 * M); b.ao = (float*)(base + 178 * M); b.lf = (float*)(base + 194 * M); b.cum = (float*)(base + 195 * M); b.eid = (int*)(base + 196 * M); b.ew = (float*)(base + 197 * M); return b; }
__host__ inline Bufs carve_small(char* base) { const size_t M = 1u << 20; Bufs b; b.hbuf = (float*)(base); b.z = (float*)(base + 4 * M); b.gated = (float*)(base + 20 * M); b.kvf = (float*)(base + 28 * M);
    b.qg = (float*)(base + 37 * M); b.ao = (float*)(base + 45 * M); b.lf = (float*)(base + 49 * M); b.cum = (float*)(base + 50 * M); b.eid = (int*)(base + 51 * M); b.ew = (float*)(base + 52 * M); return b; }
__global__ void sigm_k(const float* qg, float* o) { const int i = blockIdx.x * 256 + threadIdx.x, t = i / D, c = i % D; o[i] = 1.f / (1.f + expf(-qg[(size_t)t * 2 * D + D + c])); }
inline void run_batch(void* const* d_in, const float* xb, float* ob, const Bufs& B, int n, hipStream_t st, float* const* snap, int* const* seid, float* const* sew) {
    const float* a_norm = (const float*)d_in[1]; const float* a_w_in = (const float*)d_in[2]; const float* a_b_in = (const float*)d_in[3];
    const float* a_v_norm = (const float*)d_in[4]; const float* a_w_s = (const float*)d_in[5]; const float* a_b_s = (const float*)d_in[6]; const float* a_w_out = (const float*)d_in[7];
    const float* kv_norm = (const float*)d_in[8]; const float* kv_w = (const float*)d_in[9]; const float* kv_b_f = (const float*)d_in[10]; const float* k_norm = (const float*)d_in[11];
    const float* b_norm = (const float*)d_in[12]; const float* b_w_qg = (const float*)d_in[13]; const float* q_norm = (const float*)d_in[14]; const float* b_w_out = (const float*)d_in[15];
    const float* m_norm = (const float*)d_in[16]; const float* m_w_group = (const float*)d_in[17]; const float* m_b_group = (const float*)d_in[18]; const float* m_w_expert = (const float*)d_in[19];
    const float* m_b_expert = (const float*)d_in[20]; const float* m_w1 = (const float*)d_in[21]; const float* m_w3 = (const float*)d_in[22]; const float* m_w2 = (const float*)d_in[23];
    const size_t rowb = (size_t)n * D * 4;
    rmsnorm<<<n, 256, 0, st>>>(xb, D, a_norm, B.hbuf, D, D);
    gemm<1><<<dim3(ZW / 64, n / 64), 256, 0, st>>>(B.hbuf, D, a_w_in, ZW, B.z, ZW, a_b_in, nullptr, 0, n, ZW, D);
    rmsnorm<<<n, 256, 0, st>>>(B.z + SW, ZW, a_v_norm, B.z + SW, ZW, SW);
    sgu<<<dim3(SW / 256, n), 256, 0, st>>>(B.z, a_w_s, a_b_s, B.gated);
    gemm<2><<<dim3(D / 64, n / 64), 256, 0, st>>>(B.gated, SW, a_w_out, D, ob, D, nullptr, xb, D, n, D, SW);
    if (snap) (void)hipMemcpyAsync(snap[0], ob, rowb, hipMemcpyDeviceToDevice, st);
    rmsnorm<<<n, 256, 0, st>>>(ob, D, m_norm, B.hbuf, D, D);
    route<<<n, 64, 0, st>>>(B.hbuf, m_w_group, m_b_group, m_w_expert, m_b_expert, B.eid, B.ew);
    if (seid) { (void)hipMemcpyAsync(seid[0], B.eid, (size_t)n * 8, hipMemcpyDeviceToDevice, st); (void)hipMemcpyAsync(sew[0], B.ew, (size_t)n * 8, hipMemcpyDeviceToDevice, st); }
    moe_ffn<<<n, 256, 0, st>>>(B.hbuf, ob, B.eid, B.ew, m_w1, m_w3, m_w2, ob);
    if (snap) (void)hipMemcpyAsync(snap[1], ob, rowb, hipMemcpyDeviceToDevice, st);
    rmsnorm<<<n, 256, 0, st>>>(ob, D, kv_norm, B.hbuf, D, D);
    gemm<0><<<dim3((KVW + 63) / 64, n / 64), 256, 0, st>>>(B.hbuf, D, kv_w, KVW, B.kvf, KVW, nullptr, nullptr, 0, n, KVW, D);
    headnorm<<<n, 1024, 0, st>>>(B.kvf, KVW, k_norm);
    logf_k<<<n * H / 256, 256, 0, st>>>(B.kvf, kv_b_f, B.lf);
    cumsum_k<<<1, 64, 0, st>>>(B.lf, B.cum, n);
    rmsnorm<<<n, 256, 0, st>>>(ob, D, b_norm, B.hbuf, D, D);
    gemm<0><<<dim3(2 * D / 64, n / 64), 256, 0, st>>>(B.hbuf, D, b_w_qg, 2 * D, B.qg, 2 * D, nullptr, nullptr, 0, n, 2 * D, D);
    headnorm<<<n, 1024, 0, st>>>(B.qg, 2 * D, q_norm);
    attn<<<dim3(n, H), 64, 0, st>>>(B.qg, B.kvf, B.cum, B.ao);
    gemm<2><<<dim3(D / 64, n / 64), 256, 0, st>>>(B.ao, D, b_w_out, D, ob, D, nullptr, ob, D, n, D, D);
    if (snap) (void)hipMemcpyAsync(snap[2], ob, rowb, hipMemcpyDeviceToDevice, st);
    rmsnorm<<<n, 256, 0, st>>>(ob, D, m_norm + D, B.hbuf, D, D);
    route<<<n, 64, 0, st>>>(B.hbuf, m_w_group + D * NG, m_b_group + NG, m_w_expert + D * NE, m_b_expert + NE, B.eid, B.ew);
    if (seid) { (void)hipMemcpyAsync(seid[1], B.eid, (size_t)n * 8, hipMemcpyDeviceToDevice, st); (void)hipMemcpyAsync(sew[1], B.ew, (size_t)n * 8, hipMemcpyDeviceToDevice, st); }
    moe_ffn<<<n, 256, 0, st>>>(B.hbuf, ob, B.eid, B.ew, m_w1 + (size_t)NE * D * DE, m_w3 + (size_t)NE * D * DE, m_w2 + (size_t)NE * DE * D, ob);
    if (snap) (void)hipMemcpyAsync(snap[3], ob, rowb, hipMemcpyDeviceToDevice, st);
}
template <bool BF> __global__ void cmp_k(const void* fast, int ldf, const float* naive, int ldn, int cols, float nscale, float* err, int slot) {
    const int r = blockIdx.x; float d2 = 0.f, n2 = 0.f;
    for (int c = threadIdx.x; c < cols; c += 256) { float f; if (BF) { const unsigned short w = ((const unsigned short*)fast)[(size_t)r * ldf + c]; f = __uint_as_float((unsigned)w << 16); } else f = ((const float*)fast)[(size_t)r * ldf + c];
        const float nv_ = naive[(size_t)r * ldn + c] * nscale; float d = f - nv_; if (!(d == d) || fabsf(d) > 1e30f) d = 1e15f; d2 += d * d; n2 += nv_ * nv_; }
    for (int o = 1; o < 64; o <<= 1) { d2 += __shfl_xor(d2, o); n2 += __shfl_xor(n2, o); }
    if ((threadIdx.x & 63) == 0) { atomicAdd(err + 2 * slot, d2); atomicAdd(err + 2 * slot + 1, n2); }
}
__global__ void cmp_route(const int* LA, const float* LW, const unsigned* cnt  , const int* eid, const float* ew, int tok0, int n, float* err, int slot) {
    const int i = blockIdx.x * 64 + threadIdx.x; if (i >= 2 * n) return; const int e = eid[i]; const int a = 2 * tok0 + i; const int c = (int)cnt[e * 64]; bool ok = false;
    for (int p = 0; p < c && p < LCAP; ++p) if (LA[(size_t)e * LCAP + p] == a) { ok = fabsf(LW[(size_t)e * LCAP + p] - ew[i]) <= 0.02f * fabsf(ew[i]) + 1e-4f; break; }
    atomicAdd(err + 2 * slot, ok ? 0.f : 1.f); atomicAdd(err + 2 * slot + 1, 1.f);
}
__global__ void encode_k(float* out, const float* nout, const float* err, int nslot, float tol) {
    int f = -1; for (int s = 0; s < nslot; ++s) { const float d = err[2 * s], n = err[2 * s + 1]; const float tl = (s == 3 || s == 13) ? 0.03f : tol; if (!(n > 0.f) || !(d <= tl * n)) { f = s; break; } }
    if (f < 0) return; const float k = 1.f + 0.1f * (float)(f + 1);
    for (size_t i = (size_t)blockIdx.x * 256 + threadIdx.x; i < (size_t)T * D; i += (size_t)gridDim.x * 256) out[i] = nout[i] * k;
}
}
#endif
#if DBG
#ifndef DBG_NCHK
#define DBG_NCHK 1024
#endif
#ifndef DBG_CB
#define DBG_CB 0
#endif
static_assert(MK_PER_PHASE == 1, "DBG needs one launch per phase");
namespace nv {
struct Ctx { hipStream_t st; float* out; char* ws; Bufs Bw; float* snap[4]; int* seid[2]; float* sew[2]; float* sgate; float* err; } g;
inline void after(int p) {
    const int n = DBG_NCHK; const size_t tok0 = (size_t)DBG_CB * S; hipStream_t st = g.st; char* ws = g.ws;
    const unsigned short* ZB = (const unsigned short*)(ws + WS_BIG); const unsigned short* GY = (const unsigned short*)(ws + WS_GY); const unsigned short* XB = (const unsigned short*)(ws + WS_XB);
    const unsigned short* KB = ZB; const unsigned short* VB = ZB + (size_t)T * D; const unsigned short* QB = ZB + (size_t)2 * T * D; const unsigned short* GB = ZB + (size_t)3 * T * D;
    const int* LA = (const int*)(ws + WS_LA); const float* LW = (const float*)(ws + WS_LW); const unsigned* cnt = (const unsigned*)(ws + WS_CTL) + CW_CNT;
    if (p == 1) cmp_k<true><<<n, 256, 0, st>>>(ZB + tok0 * ZW, ZW, g.Bw.z, ZW, SW, 1.f, g.err, 0);
    if (p == 2) cmp_k<true><<<n, 256, 0, st>>>(GY + tok0 * SW, SW, g.Bw.gated, SW, SW, 1.f, g.err, 1);
    if (p == 3) cmp_k<false><<<n, 256, 0, st>>>(g.out + tok0 * D, D, g.snap[0], D, D, 1.f, g.err, 2);
    if (p == 4) cmp_route<<<(2 * n + 63) / 64, 64, 0, st>>>(LA, LW, cnt, g.seid[0], g.sew[0], (int)tok0, n, g.err, 3);
    if (p == 7) { cmp_k<false><<<n, 256, 0, st>>>(g.out + tok0 * D, D, g.snap[1], D, D, 1.f, g.err, 4); cmp_k<true><<<n, 256, 0, st>>>(XB + tok0 * D, D, g.snap[1], D, D, 1.f, g.err, 5); }
    if (p == 8) { cmp_k<true><<<n, 256, 0, st>>>(KB + tok0 * D, D, g.Bw.kvf, KVW, D, 1.f, g.err, 6); cmp_k<true><<<n, 256, 0, st>>>(VB + tok0 * D, D, g.Bw.kvf + D, KVW, D, 1.f, g.err, 7);
        cmp_k<true><<<n, 256, 0, st>>>(QB + tok0 * D, D, g.Bw.qg, 2 * D, D, 0.125f * LOG2E, g.err, 8); cmp_k<true><<<n, 256, 0, st>>>(GB + tok0 * D, D, g.sgate, D, D, 1.f, g.err, 9);
        cmp_k<false><<<H, 256, 0, st>>>((const float*)(ws + WS_CUM) + (size_t)DBG_CB * H * S, S, g.Bw.cum, S, n, 1.f, g.err, 10); }
    if (p == 9) cmp_k<true><<<n, 256, 0, st>>>(QB + tok0 * D, D, g.Bw.ao, D, D, 1.f, g.err, 11);
    if (p == 10) cmp_k<false><<<n, 256, 0, st>>>(g.out + tok0 * D, D, g.snap[2], D, D, 1.f, g.err, 12);
    if (p == 11) cmp_route<<<(2 * n + 63) / 64, 64, 0, st>>>(LA, LW, cnt + 32 * 64, g.seid[1], g.sew[1], (int)tok0, n, g.err, 13);
    if (p == 14) cmp_k<false><<<n, 256, 0, st>>>(g.out + tok0 * D, D, g.snap[3], D, D, 1.f, g.err, 14);
}
}
#undef DBG_AFTER_PHASE
#define DBG_AFTER_PHASE(p) nv::after(p)
#define DBG_BEGIN() do { const size_t M_ = 1u << 20; char* db = (char*)d_ws + 400 * M_; nv::g.st = stream; nv::g.out = (float*)d_out; nv::g.ws = (char*)d_ws; nv::g.Bw = nv::carve_small(db); \
    for (int i_ = 0; i_ < 4; ++i_) nv::g.snap[i_] = (float*)(db + (56 + 4 * i_) * M_); nv::g.seid[0] = (int*)(db + 72 * M_); nv::g.seid[1] = (int*)(db + 73 * M_); nv::g.sew[0] = (float*)(db + 74 * M_); nv::g.sew[1] = (float*)(db + 75 * M_); \
    nv::g.sgate = (float*)(db + 76 * M_); float* wout_ = (float*)(db + 80 * M_); nv::g.err = (float*)(db + 84 * M_); (void)hipMemsetAsync(nv::g.err, 0, 4096, stream); \
    nv::run_batch(d_in, (const float*)d_in[0] + (size_t)DBG_CB * S * D, wout_, nv::g.Bw, DBG_NCHK, stream, nv::g.snap, nv::g.seid, nv::g.sew); \
    nv::sigm_k<<<DBG_NCHK * D / 256, 256, 0, stream>>>(nv::g.Bw.qg, nv::g.sgate); } while (0)
#define DBG_END() do { const size_t M_ = 1u << 20; nv::Bufs Bf = nv::carve((char*)d_ws + 2 * M_); float* nout = (float*)((char*)d_ws + 300 * M_); \
    for (int b_ = 0; b_ < NB; ++b_) nv::run_batch(d_in, (const float*)d_in[0] + (size_t)b_ * S * D, nout + (size_t)b_ * S * D, Bf, S, stream, nullptr, nullptr, nullptr); \
    nv::encode_k<<<1024, 256, 0, stream>>>((float*)d_out, nout, nv::g.err, 15, 2e-3f); } while (0)
#else
#define DBG_BEGIN() do { } while (0)
#define DBG_END() do { } while (0)
#endif
extern "C" void kernel_launch(void* const* d_in, const int* in_sizes, int n_in, void* d_out, int out_size, void* d_ws, size_t ws_size, hipStream_t stream) {
    static int grid = 0;
    if (grid == 0) {
        if (n_in != 24 || out_size != T * D || ws_size < WS_END) { grid = -1; return; }
        int dev = 0, cus = 0;
        if (hipGetDevice(&dev) != hipSuccess || hipDeviceGetAttribute(&cus, hipDeviceAttributeMultiprocessorCount, dev) != hipSuccess) { grid = -1; return; }
        if (hipFuncSetAttribute((const void*)fwd, hipFuncAttributeMaxDynamicSharedMemorySize, LDS_BYTES) != hipSuccess) { grid = -1; return; }
        int per_cu = 0; (void)hipOccupancyMaxActiveBlocksPerMultiprocessor(&per_cu, (const void*)fwd, NWAVES * 64, LDS_BYTES); (void)hipGetLastError();
        grid = cus;
    }
    if (grid < 0) return;
    (void)hipMemsetAsync((char*)d_ws + WS_CTL, 0, CTL_ZERO_BYTES, stream);
    DBG_BEGIN();
    Args a{};
    for (int i = 0; i < 24; ++i) a.in[i] = (const float*)d_in[i];
    a.out = (float*)d_out; a.ws = (unsigned char*)d_ws;
#if MK_PER_PHASE
    for (int p = 0; p < NPH; ++p) { a.ph_lo = p; a.ph_hi = p + 1; hipLaunchKernelGGL(fwd, dim3(grid), dim3(NWAVES * 64), LDS_BYTES, stream, a); DBG_AFTER_PHASE(p); }
    DBG_END();
#else
    a.ph_lo = 0; a.ph_hi = NPH; hipLaunchKernelGGL(fwd, dim3(grid), dim3(NWAVES * 64), LDS_BYTES, stream, a);
#endif
}
```

```cpp
#include <hip/hip_bf16.h>
#include <cmath>
#include <hip/hip_runtime.h>

#include <cstdint>


#ifndef DBG
#define DBG 0
#endif
#if DBG
#define MK_PER_PHASE 1
#endif
#ifndef MK_PER_PHASE
#define MK_PER_PHASE 0
#endif
#ifndef NCVT
#define NCVT 51
#endif
#ifndef W13_IN_P6
#define W13_IN_P6 (NE * 80)
#endif
#ifndef TIMEMASK
#define TIMEMASK 0
#endif
#ifndef DBG_AFTER_PHASE
#define DBG_AFTER_PHASE(p) do { } while (0)
#endif

constexpr int D = 1024, NB = 4, S = 4096, T = NB * S, SW = 2048, ZW = 4096, H = 16, HD = 64, NG = 4, EPG = 8, NE = 32, DE = 512, KVW = 2 * D + H;
constexpr int LCAP = 16384;
constexpr int HID_ROWS = 2 * T + NE * 256;
constexpr float EPS = 1e-6f;
constexpr float LOG2E = 1.4426950408889634f;

#define LAS __attribute__((address_space(3)))
#define GAS __attribute__((address_space(1)))

namespace pg8 {
#define PG8_LAS __attribute__((address_space(3)))
typedef unsigned short bf16_t;
typedef short bf16x8 __attribute__((ext_vector_type(8)));
typedef float f32x4 __attribute__((ext_vector_type(4)));
typedef float f32x2 __attribute__((ext_vector_type(2)));
typedef unsigned u32x4 __attribute__((ext_vector_type(4)));
typedef unsigned u32x2 __attribute__((ext_vector_type(2)));
constexpr int BM = 256, BK = 64, HALF = 128, HTB = HALF * BK * 2  , STAGE_BYTES = 8 * HTB, NXCD = 8, WGM = 8;

__host__ __device__ __forceinline__ int lds_byte(int r, int c) { const int st = (r >> 4) * 2 + (c >> 5), rr = r & 15, cc = c & 31, ob = rr * 64 + cc * 2; return st * 1024 + (ob ^ (((ob >> 9) & 1) << 5)); }
__host__ __device__ __forceinline__ void stage_rc(int b, int& R, int& C) { const int st = b / 1024, sb = b % 1024, swz = sb ^ (((sb >> 9) & 1) << 5); R = (st >> 1) * 16 + swz / 64; C = (st & 1) * 32 + (swz % 64) / 2; }
__host__ __device__ __forceinline__ int perm32(int rho) { const int n = rho >> 4, i = rho & 15; return 8 * (i >> 2) + 4 * n + (i & 3); }

struct Unit { int pm, pn, e, slot, hrow0; };

struct DenseOrder {
    int nM, nN, nwg, G, c;
    __device__ void init(int M, int N, int G_, int c_) { nM = M / BM; nN = N / BM; nwg = nM * nN; G = G_; c = c_; }
    __device__ bool next(int i, Unit& u) const {
        const long L = (long)i * G + c; if (L >= nwg) return false;
        int wgid = (int)L; { const int q = nwg / NXCD, r = nwg % NXCD, xcd = wgid % NXCD, off = wgid / NXCD; wgid = (xcd < r ? xcd * (q + 1) : r * (q + 1) + (xcd - r) * q) + off; }
        const int nig = WGM * nN, gid = wgid / nig, fm = gid * WGM, gsz = (nM - fm) < WGM ? (nM - fm) : WGM;
        u.pm = fm + ((wgid % nig) % gsz); u.pn = (wgid % nig) / gsz; u.e = 0; u.slot = 0; u.hrow0 = 0; return true;
    }
    __device__ __forceinline__ int a_row(const Unit& u, int r) const { return u.pm * BM + r; }
    __device__ __forceinline__ int b_row(const Unit& u) const { return u.pn * BM; }
};
template <bool GATHER> struct MoeOrder {
    const PG8_LAS int* mt; const PG8_LAS int* hb; const PG8_LAS int* rowtab; int total, G, c;
    __device__ bool next(int i, Unit& u) const {
        int L = i * G + c; if (L >= total) return false;
        int e = 0;
        for (; e < 31; ++e) { const int ue = 4 * mt[e]; if (L < ue) break; L -= ue; }
        const int m = mt[e]; u.e = e; u.pn = L / m; u.pm = L - u.pn * m; u.slot = i; u.hrow0 = hb[e] + 256 * u.pm; return true;
    }
    __device__ __forceinline__ int a_row(const Unit& u, int r) const { if constexpr (GATHER) return rowtab[u.slot * 256 + r]; else return u.hrow0 + r; }
    __device__ __forceinline__ int b_row(const Unit& u) const { return u.e * 1024 + u.pn * BM; }
};

__device__ __forceinline__ unsigned cvt_pk_bf16(float lo, float hi) { unsigned r; asm volatile("v_cvt_pk_bf16_f32 %0, %1, %2" : "=v"(r) : "v"(lo), "v"(hi)); return r; }
__device__ __forceinline__ u32x4 pack8(f32x4 a, f32x4 b) { u32x4 w; w.x = cvt_pk_bf16(a[0], a[1]); w.y = cvt_pk_bf16(a[2], a[3]); w.z = cvt_pk_bf16(b[0], b[1]); w.w = cvt_pk_bf16(b[2], b[3]); return w; }
__device__ __forceinline__ float bflo(unsigned w) { return __uint_as_float(w << 16); }
__device__ __forceinline__ float bfhi(unsigned w) { return __uint_as_float(w & 0xffff0000u); }
__device__ __forceinline__ float gelu_t(float v) { const float u = v * (1.f + 0.044715f * v * v); return v * __builtin_amdgcn_rcpf(1.f + __builtin_amdgcn_exp2f(-2.302208198f * u)); }
__device__ __forceinline__ f32x4 gelu4(f32x4 v) { return (f32x4){gelu_t(v[0]), gelu_t(v[1]), gelu_t(v[2]), gelu_t(v[3])}; }
__device__ __forceinline__ float sigm(float v) { return __builtin_amdgcn_rcpf(1.f + __builtin_amdgcn_exp2f(-LOG2E * v)); }
__device__ __forceinline__ float sq4(f32x4 v) { return (v[0] * v[0] + v[1] * v[1]) + (v[2] * v[2] + v[3] * v[3]); }

struct EpiIn {
    static constexpr bool PERM = true;
    bf16_t* Z; const float* rstd; const float* bias; float* ssv;
    __device__ __forceinline__ void operator()(const f32x4 (&acc)[2][2][4][2], const Unit& u, int wr, int wc, int fr, int fq) const {
        const int row0 = u.pm * BM + wr * 64 + fr, col0 = u.pn * BM + wc * 32 + 8 * fq;
        f32x4 bv[2][2];
#pragma unroll
        for (int bj = 0; bj < 2; ++bj)
#pragma unroll
            for (int n = 0; n < 2; ++n) bv[bj][n] = *(const f32x4*)(bias + col0 + bj * HALF + 4 * n);
        const bool vhalf = u.pn >= 8;
#pragma unroll
        for (int ai = 0; ai < 2; ++ai)
#pragma unroll
            for (int m = 0; m < 4; ++m) { const int row = row0 + ai * HALF + m * 16; const float rs = rstd[row]; float ss = 0.f;
#pragma unroll
                for (int bj = 0; bj < 2; ++bj) { const f32x4 v0 = gelu4(acc[ai][bj][m][0] * rs + bv[bj][0]), v1 = gelu4(acc[ai][bj][m][1] * rs + bv[bj][1]);
                    ss += sq4(v0) + sq4(v1); *(u32x4*)(Z + (size_t)row * ZW + col0 + bj * HALF) = pack8(v0, v1); }
                if (vhalf) { ss += __shfl_xor(ss, 16); ss += __shfl_xor(ss, 32); if (fq == 0) ssv[(size_t)row * 32 + (u.pn - 8) * 4 + wc] = ss; } }
    }
};
struct EpiRes {
    static constexpr bool PERM = true;
    const float* R; float* O; bf16_t* XB;
    __device__ __forceinline__ void operator()(const f32x4 (&acc)[2][2][4][2], const Unit& u, int wr, int wc, int fr, int fq) const {
        const int row0 = u.pm * BM + wr * 64 + fr, col0 = u.pn * BM + wc * 32 + 8 * fq;
#pragma unroll
        for (int ai = 0; ai < 2; ++ai)
#pragma unroll
            for (int m = 0; m < 4; ++m) { const size_t off = (size_t)(row0 + ai * HALF + m * 16) * D + col0;
#pragma unroll
                for (int bj = 0; bj < 2; ++bj) { const f32x4 r0 = *(const f32x4*)(R + off + bj * HALF), r1 = *(const f32x4*)(R + off + bj * HALF + 4);
                    const f32x4 v0 = acc[ai][bj][m][0] + r0, v1 = acc[ai][bj][m][1] + r1;
                    *(f32x4*)(O + off + bj * HALF) = v0; *(f32x4*)(O + off + bj * HALF + 4) = v1; *(u32x4*)(XB + off + bj * HALF) = pack8(v0, v1); } }
    }
};
struct EpiKVQG {
    static constexpr bool PERM = true;
    bf16_t* KB; const float* rstd; const float* kgain; const float* qgain;
    __device__ __forceinline__ void operator()(const f32x4 (&acc)[2][2][4][2], const Unit& u, int wr, int wc, int fr, int fq) const {
        const int sec = u.pn >> 2, head = (u.pn & 3) * 4 + wc, row0 = u.pm * BM + wr * 64 + fr;
        bf16_t* base = KB + (size_t)sec * T * D + head * HD + 8 * fq;
        const bool nrm = (sec == 0) || (sec == 2); const float* g = (sec == 0) ? kgain : qgain; const float post = (sec == 2) ? 0.125f * LOG2E : 1.f;
        f32x4 gv[2][2];
#pragma unroll
        for (int bj = 0; bj < 2; ++bj)
#pragma unroll
            for (int n = 0; n < 2; ++n) gv[bj][n] = *(const f32x4*)(g + 32 * bj + 8 * fq + 4 * n) * post;
#pragma unroll
        for (int ai = 0; ai < 2; ++ai)
#pragma unroll
            for (int m = 0; m < 4; ++m) { const int row = row0 + ai * HALF + m * 16; const float rs = rstd[row];
                f32x4 v[2][2];
#pragma unroll
                for (int bj = 0; bj < 2; ++bj)
#pragma unroll
                    for (int n = 0; n < 2; ++n) v[bj][n] = acc[ai][bj][m][n] * rs;
                if (nrm) { float ss = (sq4(v[0][0]) + sq4(v[0][1])) + (sq4(v[1][0]) + sq4(v[1][1])); ss += __shfl_xor(ss, 16); ss += __shfl_xor(ss, 32);
                    const float r = __builtin_amdgcn_rsqf(ss * (1.f / 64.f) + EPS);
#pragma unroll
                    for (int bj = 0; bj < 2; ++bj)
#pragma unroll
                        for (int n = 0; n < 2; ++n) v[bj][n] = v[bj][n] * r * gv[bj][n]; }
                else if (sec == 3) {
#pragma unroll
                    for (int bj = 0; bj < 2; ++bj)
#pragma unroll
                        for (int n = 0; n < 2; ++n) v[bj][n] = (f32x4){sigm(v[bj][n][0]), sigm(v[bj][n][1]), sigm(v[bj][n][2]), sigm(v[bj][n][3])}; }
#pragma unroll
                for (int bj = 0; bj < 2; ++bj) *(u32x4*)(base + (size_t)row * D + 32 * bj) = pack8(v[bj][0], v[bj][1]); }
    }
};
struct EpiMoe1 {
    static constexpr bool PERM = true;
    bf16_t* HID; const PG8_LAS float* trs;
    __device__ __forceinline__ void operator()(const f32x4 (&acc)[2][2][4][2], const Unit& u, int wr, int wc, int fr, int fq) const {
#pragma unroll
        for (int ai = 0; ai < 2; ++ai)
#pragma unroll
            for (int m = 0; m < 4; ++m) { const int pos = ai * HALF + wr * 64 + m * 16 + fr; const float rs = trs[u.slot * 256 + pos];
                f32x4 hv[2];
#pragma unroll
                for (int n = 0; n < 2; ++n) { const f32x4 a = acc[ai][0][m][n] * rs, b = acc[ai][1][m][n] * rs;
                    hv[n] = (f32x4){a[0] * sigm(a[0]) * b[0], a[1] * sigm(a[1]) * b[1], a[2] * sigm(a[2]) * b[2], a[3] * sigm(a[3]) * b[3]}; }
                *(u32x4*)(HID + (size_t)(u.hrow0 + pos) * DE + u.pn * HALF + wc * 32 + 8 * fq) = pack8(hv[0], hv[1]); }
    }
};
struct EpiMoe2 {
    static constexpr bool PERM = true;
    bf16_t* Y2; const PG8_LAS int* ta; const PG8_LAS float* tw;
    __device__ __forceinline__ void operator()(const f32x4 (&acc)[2][2][4][2], const Unit& u, int wr, int wc, int fr, int fq) const {
        const int col0 = u.pn * BM + wc * 32 + 8 * fq;
#pragma unroll
        for (int ai = 0; ai < 2; ++ai)
#pragma unroll
            for (int m = 0; m < 4; ++m) { const int pos = ai * HALF + wr * 64 + m * 16 + fr; const int a = ta[u.slot * 256 + pos]; const float w = tw[u.slot * 256 + pos];
                if (a >= 0) {
#pragma unroll
                    for (int bj = 0; bj < 2; ++bj) *(u32x4*)(Y2 + (size_t)a * D + col0 + bj * HALF) = pack8(acc[ai][bj][m][0] * w, acc[ai][bj][m][1] * w); } }
    }
};

template <class Epi, class Sched, bool ALIGN_EPI = false, bool SP2 = false>
__device__ __forceinline__ void gemm_phase(PG8_LAS unsigned char* lds, const bf16_t* Aptr, const bf16_t* Btptr, const int K, const Sched& S, const Epi& E) {
    static_assert(SP2, "only the SP2 loop is kept");
    const int tid = threadIdx.x, wid = __builtin_amdgcn_readfirstlane(tid >> 6), lane = tid & 63, wr = wid >> 2, wc = wid & 3, fr = lane & 15, fq = lane >> 4;
    const int nt = K / BK;
    unsigned voffB[2]; int RA[2], CA[2];
#pragma unroll
    for (int i = 0; i < 2; ++i) { int R, C; stage_rc(tid * 16 + i * 8192, R, C); const int Rb = Epi::PERM ? ((R & ~31) + perm32(R & 31)) : R;
        RA[i] = R; CA[i] = C; voffB[i] = (unsigned)(Rb * K + C) * 2u; }
    unsigned vc[2][2], vn[2][2];
#define PG8_AOFF(dst, unit) do { _Pragma("unroll") for (int _h = 0; _h < 2; ++_h) _Pragma("unroll") for (int _i = 0; _i < 2; ++_i) \
        dst[_h][_i] = (unsigned)(S.a_row(unit, _h * HALF + RA[_i]) * K + CA[_i]) * 2u; } while (0)
    const size_t kstep = (size_t)(BK * 2);
    const size_t hstep = (size_t)HALF * K * 2;
    const unsigned ldsw = (unsigned)wid * 1024u;
    const int aoff = lds_byte(wr * 64 + fr, fq * 8), boff = lds_byte(wc * 32 + fr, fq * 8);
#define PG8_SA(b, h) (((b) * 2 + (h)) * HTB)
#define PG8_SB(b, h) ((4 + (b) * 2 + (h)) * HTB)
#define PG8_STAGE(bufoff, gbase, voff) do { _Pragma("unroll") for (int _i = 0; _i < 2; ++_i) \
        __builtin_amdgcn_global_load_lds((const unsigned*)((const char*)(gbase) + (voff)[_i]), (PG8_LAS unsigned*)(lds + (bufoff) + ldsw + _i * 8192), 16, 0, 0); } while (0)
#define PG8_LDA(dst, b, h) do { _Pragma("unroll") for (int m = 0; m < 4; ++m) _Pragma("unroll") for (int k = 0; k < 2; ++k) dst[m][k] = *(const PG8_LAS bf16x8*)(lds + PG8_SA(b, h) + aoff + m * 2048 + k * 1024); } while (0)
#define PG8_LDB(dst, b, h) do { _Pragma("unroll") for (int n = 0; n < 2; ++n) _Pragma("unroll") for (int k = 0; k < 2; ++k) dst[n][k] = *(const PG8_LAS bf16x8*)(lds + PG8_SB(b, h) + boff + n * 2048 + k * 1024); } while (0)
#define PG8_MMA(ai, bj, At, Bt) do { __builtin_amdgcn_s_setprio(1); _Pragma("unroll") for (int m = 0; m < 4; ++m) _Pragma("unroll") for (int n = 0; n < 2; ++n) _Pragma("unroll") for (int k = 0; k < 2; ++k) \
        acc[ai][bj][m][n] = __builtin_amdgcn_mfma_f32_16x16x32_bf16(Bt[n][k], At[m][k], acc[ai][bj][m][n], 0, 0, 0); __builtin_amdgcn_s_setprio(0); } while (0)
#define PG8_WAIT_V(n) asm volatile("s_waitcnt vmcnt(" #n ")" ::: "memory")
#define PG8_WAIT_L(n) asm volatile("s_waitcnt lgkmcnt(" #n ")" ::: "memory")
#define PG8_BAR __builtin_amdgcn_s_barrier()
#define PG8_SCHED __builtin_amdgcn_sched_barrier(0)
    Unit cur, nxt; int ui = 0;
    if (!S.next(0, cur)) return;
    f32x4 acc[2][2][4][2];
#pragma unroll
    for (int a = 0; a < 2; ++a)
#pragma unroll
        for (int b = 0; b < 2; ++b)
#pragma unroll
            for (int m = 0; m < 4; ++m)
#pragma unroll
                for (int n = 0; n < 2; ++n) acc[a][b][m][n] = (f32x4){0.f, 0.f, 0.f, 0.f};
    bf16x8 At[4][2], B0[2][2], B1[2][2];
    const char* const Ab = (const char*)Aptr; const char* cB = (const char*)Btptr + (size_t)S.b_row(cur) * K * 2;
    PG8_AOFF(vc, cur);
    if constexpr (SP2) {
        PG8_STAGE(PG8_SB(0, 0), cB, voffB); PG8_STAGE(PG8_SB(0, 1), cB + hstep, voffB); PG8_STAGE(PG8_SA(0, 0), Ab, vc[0]); PG8_STAGE(PG8_SA(0, 1), Ab, vc[1]);
        if (wr == 1) PG8_BAR;
        PG8_WAIT_V(2); PG8_BAR;
        PG8_STAGE(PG8_SB(1, 0), cB + kstep, voffB); PG8_STAGE(PG8_SA(1, 0), Ab + kstep, vc[0]); PG8_STAGE(PG8_SB(1, 1), cB + hstep + kstep, voffB);
        PG8_WAIT_V(6); PG8_BAR;
    }
    for (;;) {
        const bool has_next = S.next(ui + 1, nxt);
        const char* nB = has_next ? (const char*)Btptr + (size_t)S.b_row(nxt) * K * 2 : cB;
        if (has_next) { PG8_AOFF(vn, nxt); } else { _Pragma("unroll") for (int _h = 0; _h < 2; ++_h) _Pragma("unroll") for (int _i = 0; _i < 2; ++_i) vn[_h][_i] = vc[_h][_i]; }
        for (int t = 0; t < nt; t += 2) {
            const bool last = (t == nt - 2);
            const char* a1 = Ab + (size_t)(t + 1) * kstep;
            const char* a2 = last ? Ab : Ab + (size_t)(t + 2) * kstep; const char* b2 = last ? nB : cB + (size_t)(t + 2) * kstep;
            const char* a3 = a2 + kstep; const char* b3 = b2 + kstep;
            unsigned v2[2][2];
#pragma unroll
            for (int _h = 0; _h < 2; ++_h)
#pragma unroll
                for (int _i = 0; _i < 2; ++_i) v2[_h][_i] = last ? vn[_h][_i] : vc[_h][_i];
            if constexpr (SP2) {
            PG8_LDB(B0, 0, 0); PG8_LDB(B1, 0, 1); PG8_SCHED; PG8_LDA(At, 0, 0); PG8_STAGE(PG8_SA(1, 1), a1, vc[1]);
            PG8_WAIT_V(8); PG8_WAIT_L(0); PG8_BAR; PG8_MMA(0, 0, At, B0); PG8_MMA(0, 1, At, B1); PG8_BAR; PG8_SCHED;
            PG8_LDA(At, 0, 1); PG8_STAGE(PG8_SB(0, 0), b2, voffB); PG8_STAGE(PG8_SB(0, 1), b2 + hstep, voffB); PG8_STAGE(PG8_SA(0, 0), a2, v2[0]);
            PG8_WAIT_V(8); PG8_WAIT_L(0); PG8_BAR; PG8_MMA(1, 0, At, B0); PG8_MMA(1, 1, At, B1); PG8_BAR; PG8_SCHED;
            PG8_LDB(B0, 1, 0); PG8_LDB(B1, 1, 1); PG8_SCHED; PG8_LDA(At, 1, 0); PG8_STAGE(PG8_SA(0, 1), a2, v2[1]);
            PG8_WAIT_V(8); PG8_WAIT_L(0); PG8_BAR; PG8_MMA(0, 0, At, B0); PG8_MMA(0, 1, At, B1); PG8_BAR; PG8_SCHED;
            PG8_LDA(At, 1, 1); PG8_STAGE(PG8_SB(1, 0), b3, voffB); PG8_STAGE(PG8_SB(1, 1), b3 + hstep, voffB); PG8_STAGE(PG8_SA(1, 0), a3, v2[0]);
            PG8_WAIT_V(8); PG8_WAIT_L(0); PG8_BAR; PG8_MMA(1, 0, At, B0); PG8_MMA(1, 1, At, B1); PG8_BAR; PG8_SCHED;
            }
        }
        if constexpr (ALIGN_EPI) { if (wr == 0) PG8_BAR; }
        E(acc, cur, wr, wc, fr, fq);
        if (!has_next) break;
#pragma unroll
        for (int a = 0; a < 2; ++a)
#pragma unroll
            for (int b = 0; b < 2; ++b)
#pragma unroll
                for (int m = 0; m < 4; ++m)
#pragma unroll
                    for (int n = 0; n < 2; ++n) acc[a][b][m][n] = (f32x4){0.f, 0.f, 0.f, 0.f};
        cur = nxt; cB = nB; ++ui;
#pragma unroll
        for (int _h = 0; _h < 2; ++_h)
#pragma unroll
            for (int _i = 0; _i < 2; ++_i) vc[_h][_i] = vn[_h][_i];
        if constexpr (ALIGN_EPI) { if (wr == 1) PG8_BAR; }
    }
    PG8_WAIT_V(0);
    if constexpr (!ALIGN_EPI) { if (wr == 0) PG8_BAR; }
    PG8_BAR;
#undef PG8_AOFF
#undef PG8_SA
#undef PG8_SB
#undef PG8_STAGE
#undef PG8_LDA
#undef PG8_LDB
#undef PG8_MMA
#undef PG8_WAIT_V
#undef PG8_WAIT_L
#undef PG8_BAR
#undef PG8_SCHED
}
}


namespace attn_body {
using bf16=__hip_bfloat16;
using bf16x8=__attribute__((ext_vector_type(8)))short;
using s16x4=__attribute__((ext_vector_type(4)))short;
using f32x16=__attribute__((ext_vector_type(16)))float;
using u32x4=__attribute__((ext_vector_type(4)))unsigned;
using f32x4v=__attribute__((ext_vector_type(4)))float;
constexpr int BATCH=4,NHEAD=16,SEQ=4096,D=64,DM=NHEAD*D;
constexpr int NW=8,QBLK=32,QB=QBLK*NW,KVBLK=64,NQB=SEQ/QB;
constexpr int ATTN_PITCH=DM, ATTN_UNIT_ROWS=QB;
__device__ __forceinline__ int crow(int r,int hi){return (r&3)+8*(r>>2)+4*hi;}
#define SBAR() __builtin_amdgcn_sched_barrier(0)
__device__ __forceinline__ void cmask(f32x16&p0,f32x16&p1,int jb,int qrel,int hi){
  const float NEG=-INFINITY; int kb=64*jb+4*hi;
  #pragma unroll
  for(int r=0;r<16;++r){int kv=kb+(r&3)+8*(r>>2); if(kv>qrel)p0[r]=NEG; if(kv+32>qrel)p1[r]=NEG;}
}

constexpr int NSLOT=3, SLOTB=8192;
constexpr int LDS_K=0, LDS_V=NSLOT*SLOTB, LDS_WS=2*NSLOT*SLOTB, LDS_OST=LDS_WS+NW*64*4, LDS_CK=LDS_OST+NW*4096, LDS_BYTES=LDS_CK+SEQ*4;
constexpr float C2=0.125f*1.4426950408889634f;
__device__ __forceinline__ void glds16(const void*gsrc,unsigned lds_dst){unsigned keep;
  asm volatile("s_mov_b32 %0, m0\n\ts_mov_b32 m0, %2\n\ts_nop 0\n\tglobal_load_lds_dwordx4 %1, off\n\ts_mov_b32 m0, %0":"=&s"(keep):"v"(gsrc),"s"(lds_dst):"memory");}
__device__ __forceinline__ float max3f(float a,float b,float c){float r;asm("v_max3_f32 %0, %1, %2, %3":"=v"(r):"v"(a),"v"(b),"v"(c));return r;}
__device__ __forceinline__ float max2f(float a,float b){float r;asm("v_max_f32_e32 %0, %1, %2":"=v"(r):"v"(a),"v"(b));return r;}
__device__ __forceinline__ float fadd_s(float a,float b){float r;asm("v_add_f32_e32 %0, %1, %2":"=v"(r):"v"(a),"v"(b));return r;}
__device__ __forceinline__ float fsub_s(float a,float b){float r;asm("v_sub_f32_e32 %0, %1, %2":"=v"(r):"v"(a),"v"(b));return r;}
typedef float f32x2_t __attribute__((ext_vector_type(2))); typedef __bf16 bf16x2_t __attribute__((ext_vector_type(2)));
__device__ __forceinline__ unsigned cvtpk_s(float lo,float hi){f32x2_t v={lo,hi};bf16x2_t b=__builtin_convertvector(v,bf16x2_t);return __builtin_bit_cast(unsigned,b);}
#define WAIT_BAR(N) asm volatile("s_waitcnt vmcnt(" #N ") lgkmcnt(0)\n\ts_barrier":::"memory")

__device__ __forceinline__ void qkt(f32x16&p0,f32x16&p1,const char*Kslot,const bf16x8*qr,int r32,int hi){
  const char*kb=Kslot+hi*1024+r32*16;
  #pragma unroll
  for(int d0=0;d0<4;++d0){
    const bf16x8 b0=*reinterpret_cast<const bf16x8*>(kb+d0*2048);
    const bf16x8 b1=*reinterpret_cast<const bf16x8*>(kb+d0*2048+512);
    p0=__builtin_amdgcn_mfma_f32_32x32x16_bf16(b0,qr[d0],p0,0,0,0);p1=__builtin_amdgcn_mfma_f32_32x32x16_bf16(b1,qr[d0],p1,0,0,0);}
}
typedef __attribute__((address_space(3))) const char* lds_cptr;
typedef short v4i16_t __attribute__((ext_vector_type(4)));
__device__ __forceinline__ void kload8(bf16x8*kf,lds_cptr kp){
  kf[0]=*(const __attribute__((address_space(3))) bf16x8*)(kp);      kf[1]=*(const __attribute__((address_space(3))) bf16x8*)(kp+512);
  kf[2]=*(const __attribute__((address_space(3))) bf16x8*)(kp+2048); kf[3]=*(const __attribute__((address_space(3))) bf16x8*)(kp+2560);
  kf[4]=*(const __attribute__((address_space(3))) bf16x8*)(kp+4096); kf[5]=*(const __attribute__((address_space(3))) bf16x8*)(kp+4608);
  kf[6]=*(const __attribute__((address_space(3))) bf16x8*)(kp+6144); kf[7]=*(const __attribute__((address_space(3))) bf16x8*)(kp+6656);
}
__device__ __forceinline__ void kload2(bf16x8*kf,lds_cptr kp,int j){ kf[2*j]=*(const __attribute__((address_space(3))) bf16x8*)(kp+j*2048); kf[2*j+1]=*(const __attribute__((address_space(3))) bf16x8*)(kp+j*2048+512); }
__device__ __forceinline__ s16x4 vtr(lds_cptr p){ return __builtin_bit_cast(s16x4,__builtin_amdgcn_ds_read_tr16_b64_v4i16((__attribute__((address_space(3))) v4i16_t*)p)); }
__device__ __forceinline__ float rowmax(const f32x16&p0,const f32x16&p1){
  float a=max3f(p0[0],p0[1],p1[0]),b=max3f(p0[2],p0[3],p1[1]);a=max3f(a,p1[2],p1[3]);
  #pragma unroll
  for(int r=4;r<16;r+=4){a=max3f(a,p0[r],p0[r+1]);b=max3f(b,p0[r+2],p0[r+3]);a=max3f(a,p1[r],p1[r+1]);b=max3f(b,p1[r+2],p1[r+3]);}
  const float m=max2f(a,b);
  auto rr=__builtin_amdgcn_permlane32_swap(__float_as_uint(m),__float_as_uint(m),false,false);
  return max2f(__uint_as_float(rr[0]),__uint_as_float(rr[1]));
}
__device__ __forceinline__ void pv(f32x16*o,int vb,bf16x8 pa0,bf16x8 pa1,bf16x8 pa2,bf16x8 pa3){
  #pragma unroll
  for(int d0=0;d0<2;++d0){s16x4 lo[4],hi[4];
    #pragma unroll
    for(int ks=0;ks<4;++ks){
      asm volatile("ds_read_b64_tr_b16 %0,%1 offset:%c2":"=&v"(lo[ks]):"v"(vb),"i"(d0*4096+ks*1024):"memory");
      asm volatile("ds_read_b64_tr_b16 %0,%1 offset:%c2":"=&v"(hi[ks]):"v"(vb),"i"(d0*4096+ks*1024+512):"memory");}
    asm volatile("s_waitcnt lgkmcnt(0)":::"memory");SBAR();
    #define PK(k) (bf16x8){lo[k][0],lo[k][1],lo[k][2],lo[k][3],hi[k][0],hi[k][1],hi[k][2],hi[k][3]}
    o[d0]=__builtin_amdgcn_mfma_f32_32x32x16_bf16(pa0,PK(0),o[d0],0,0,0);
    o[d0]=__builtin_amdgcn_mfma_f32_32x32x16_bf16(pa1,PK(1),o[d0],0,0,0);
    o[d0]=__builtin_amdgcn_mfma_f32_32x32x16_bf16(pa2,PK(2),o[d0],0,0,0);
    o[d0]=__builtin_amdgcn_mfma_f32_32x32x16_bf16(pa3,PK(3),o[d0],0,0,0);
    #undef PK
  }
}

#ifndef ATTN_STORE16
#define ATTN_STORE16(p,v) (*(u32x4*)(p)=(v))
#endif
template<int THRL> __device__ __forceinline__ void attn_unit(int b,int h,int qb,const bf16*Q,const bf16*__restrict__ K,const bf16*__restrict__ V,const bf16*__restrict__ Gt,const float*__restrict__ cum,float TH,bf16*O,char*shm){
  const int tid=threadIdx.x,lane=tid&63,r32=lane&31,hi=lane>>5; const int wid=__builtin_amdgcn_readfirstlane(tid>>6);
  const long rowbase=(long)b*SEQ; const int q0=qb*QB;
  const bf16*Qw=Q+(rowbase+q0+wid*QBLK)*DM+h*D;
  const float*cb=cum+(long)(b*NHEAD+h)*SEQ; const int NTF=(q0+QB)/KVBLK;
  int tstart;
  { const float cq0=cb[q0]; const float ce=cb[(lane<NTF?lane:NTF-1)*KVBLK+KVBLK-1];
    __attribute__((address_space(3))) float*ckw=(__attribute__((address_space(3))) float*)((__attribute__((address_space(3))) char*)shm+LDS_CK);
    #pragma unroll
    for(int j=0;j<2;++j){ const int idx=tid*4+j*2048; if(idx<q0+QB){ const f32x4v v=*reinterpret_cast<const f32x4v*>(cb+idx); const f32x4v w=(cq0-v)*1.4426950408889634f; *(__attribute__((address_space(3))) f32x4v*)(ckw+idx)=w; } }
    const unsigned long long need=__ballot((lane<NTF)&&(ce-cq0<=TH));
    int fs=need?(int)__builtin_ctzll(need):0; if(fs>NTF-4)fs=NTF-4; tstart=__builtin_amdgcn_readfirstlane(fs&~1); }
  const bf16*Kh=K+(rowbase+(long)tstart*KVBLK)*DM+h*D,*Vh=V+(rowbase+(long)tstart*KVBLK)*DM+h*D;
  const __attribute__((address_space(3))) f32x4v* ckp=(const __attribute__((address_space(3))) f32x4v*)((lds_cptr)shm+LDS_CK)+tstart*16+hi;
  const unsigned lds0=(unsigned)(uintptr_t)shm;
  float*wsf=(float*)(shm+LDS_WS)+wid*64;
  const bf16*ksrc=Kh+(long)lane*DM+wid*8;
  const bf16*vsrc=Vh+(long)(16*(wid&3)+(lane>>2))*DM+(wid>>2)*32+(lane&3)*8;
  const unsigned kdst=lds0+LDS_K+wid*1024, vdst=lds0+LDS_V+wid*1024;
  #define DMA_K(t,slot) glds16(ksrc+(long)(t)*KVBLK*DM,(unsigned)__builtin_amdgcn_readfirstlane(kdst+(slot)))
  #define DMA_V(t,slot) glds16(vsrc+(long)(t)*KVBLK*DM,(unsigned)__builtin_amdgcn_readfirstlane(vdst+(slot)))
  const int vb0=(int)(lds0+LDS_V)+((lane>>4)&1)*32+(lane&3)*8+(4*hi+((lane&15)>>2))*64;
  const char*Kbase=shm+LDS_K; bf16x8 kf[8];
  const lds_cptr shm3=(lds_cptr)shm; const lds_cptr kp0=shm3+LDS_K+hi*1024+r32*16; const lds_cptr vp0=shm3+LDS_V+((lane>>4)&1)*32+(lane&3)*8+(4*hi+((lane&15)>>2))*64;
  const int NT=NTF-tstart;
  DMA_K(0,0);DMA_V(0,0);DMA_K(1,SLOTB);
  bf16x8 qr[4];
  #pragma unroll
  for(int d0=0;d0<4;++d0)qr[d0]=*reinterpret_cast<const bf16x8*>(&Qw[(long)r32*DM+d0*16+hi*8]);
  float mhat=0.f,l_reg=0.f;f32x16 o[2];o[0]=f32x16{};o[1]=f32x16{};
  #define CINIT(C0,C1,t) do{ const __attribute__((address_space(3))) f32x4v* cp_=ckp+(t)*16; _Pragma("unroll") for(int g_=0;g_<4;++g_){ const f32x4v b0_=cp_[2*g_],b1_=cp_[2*g_+8]; \
      _Pragma("unroll") for(int i_=0;i_<4;++i_){C0[4*g_+i_]=b0_[i_]-mhat;C1[4*g_+i_]=b1_[i_]-mhat;} } }while(0)
  const int qrel=wid*QBLK+r32;
  #define CMASK(P0,P1,t) do{int jb_=(t)-(NT-4); if(jb_>=0)cmask(P0,P1,jb_,qrel,hi);}while(0)
  bool resc=false;
  #define START(P0,P1) do{ const float rm=rowmax(P0,P1); resc=false; \
    { const float dl=rm; mhat=fadd_s(mhat,dl); \
      _Pragma("unroll") for(int r=0;r<16;++r){P0[r]=fsub_s(P0[r],dl);P1[r]=fsub_s(P1[r],dl);} } \
    _Pragma("unroll") for(int r=0;r<16;++r)P0[r]=__builtin_amdgcn_exp2f(P0[r]); }while(0)
  #define RESC() do{ if(resc){ asm volatile("s_waitcnt lgkmcnt(0)":::"memory"); \
      _Pragma("unroll") for(int d_=0;d_<2;++d_) _Pragma("unroll") for(int r=0;r<16;++r)o[d_][r]*=wsf[crow(r,hi)]; } }while(0)
  f32x16 pA0,pA1,pB0,pB1;
  int sl_prev=0,sl_cur=0,sl_next=SLOTB;
  #define ROT() do{sl_prev=sl_cur;sl_cur=sl_next;sl_next=(sl_next==(NSLOT-1)*SLOTB)?0:sl_next+SLOTB;}while(0)
  DMA_K(2,2*SLOTB);
  WAIT_BAR(3);
  CINIT(pA0,pA1,0); qkt(pA0,pA1,Kbase,qr,r32,hi);asm volatile("s_nop 15\n\ts_nop 7":"+v"(pA0),"+v"(pA1));CMASK(pA0,pA1,0);
  START(pA0,pA1);
  _Pragma("unroll") for(int r=0;r<16;++r)pA1[r]=__builtin_amdgcn_exp2f(pA1[r]);
  WAIT_BAR(0);
  DMA_K(3,0);DMA_V(1,SLOTB);
  ROT();
  kload8(kf,kp0+sl_cur);
  WAIT_BAR(2);
  s16x4 vlo[8],vhi[8]; u32x4 pw0,pw1,pw2,pw3;
  #define PKW(P,B) cvtpk_s(P[B],P[B+1])
  #define PAF(k) __builtin_bit_cast(bf16x8,pw##k)
  #define VFR(i) (bf16x8){vlo[i][0],vlo[i][1],vlo[i][2],vlo[i][3],vhi[i][0],vhi[i][1],vhi[i][2],vhi[i][3]}
  #define PIN(x) asm volatile("":"+v"(x))
  #define MX3(a,b,c) __builtin_fmaxf(__builtin_fmaxf((a),(b)),(c))
  #define GAPA(MF,A0,A1,A2,A3,W0,W1,PW) do{ MF; sacc+=A0; sacc+=A1; sacc+=A2; sacc+=A3; PIN(sacc); W0; W1; PIN(PW); SBAR(); }while(0)
  #define EX(v) __builtin_amdgcn_exp2f(v)
  #define GAPB(MF,X,B) do{ MF; X[B]=EX(X[B]); X[B+1]=EX(X[B+1]); X[B+2]=EX(X[B+2]); X[B+3]=EX(X[B+3]); PIN(X); SBAR(); }while(0)
  #define VRD(i) do{ vlo[i]=vtr(vp_+(((i)>>2)*4096+((i)&3)*1024)); vhi[i]=vtr(vp_+(((i)>>2)*4096+((i)&3)*1024+512)); }while(0)
  #define KRD(G,j) do{ if(G){ kload2(kf,kp0+sl_next,j); SBAR(); } }while(0)
  #define STEP(C0,C1,P0,P1,t,GK,GV,GL) do{ SBAR(); CINIT(C0,C1,t); SBAR(); \
    const lds_cptr vp_=vp0+sl_prev; \
    VRD(0); SBAR(); float sacc=(P0[0]+P0[1]); \
    GAPA(C0=__builtin_amdgcn_mfma_f32_32x32x16_bf16(kf[0],qr[0],C0,0,0,0), P0[2],P0[3],P0[4],P0[5],     pw0[0]=PKW(P0,0), pw0[1]=PKW(P0,2), pw0); \
    VRD(4); SBAR(); GAPA(C1=__builtin_amdgcn_mfma_f32_32x32x16_bf16(kf[1],qr[0],C1,0,0,0), P0[6],P0[7],P0[8],P0[9],     pw0[2]=PKW(P0,4), pw0[3]=PKW(P0,6), pw0); \
    VRD(1); SBAR(); GAPA(C0=__builtin_amdgcn_mfma_f32_32x32x16_bf16(kf[2],qr[1],C0,0,0,0),   P0[10],P0[11],P0[12],P0[13], pw1[0]=PKW(P0,8), pw1[1]=PKW(P0,10), pw1); \
    VRD(5); SBAR(); GAPA(C1=__builtin_amdgcn_mfma_f32_32x32x16_bf16(kf[3],qr[1],C1,0,0,0),   P0[14],P0[15],P1[0],P1[1],   pw1[2]=PKW(P0,12),pw1[3]=PKW(P0,14), pw1); \
    VRD(2); SBAR(); GAPA(C0=__builtin_amdgcn_mfma_f32_32x32x16_bf16(kf[4],qr[2],C0,0,0,0),   P1[2],P1[3],P1[4],P1[5],     pw2[0]=PKW(P1,0), pw2[1]=PKW(P1,2), pw2); \
    VRD(6); SBAR(); GAPA(C1=__builtin_amdgcn_mfma_f32_32x32x16_bf16(kf[5],qr[2],C1,0,0,0),   P1[6],P1[7],P1[8],P1[9],     pw2[2]=PKW(P1,4), pw2[3]=PKW(P1,6), pw2); \
    VRD(3); SBAR(); GAPA(C0=__builtin_amdgcn_mfma_f32_32x32x16_bf16(kf[6],qr[3],C0,0,0,0),   P1[10],P1[11],P1[12],P1[13], pw3[0]=PKW(P1,8), pw3[1]=PKW(P1,10), pw3); \
    VRD(7); SBAR(); GAPA(C1=__builtin_amdgcn_mfma_f32_32x32x16_bf16(kf[7],qr[3],C1,0,0,0),   P1[14],P1[15],0.f,0.f,       pw3[2]=PKW(P1,12),pw3[3]=PKW(P1,14), pw3); \
    l_reg+=sacc; \
    if(GK){DMA_K((t)+3,sl_cur);} if(GV){DMA_V((t)+1,sl_next);} \
    CMASK(C0,C1,t); \
    { float a=MX3(C0[0],C0[1],C1[0]),b=MX3(C0[2],C0[3],C1[1]); a=MX3(a,C1[2],C1[3]); \
      _Pragma("unroll") for(int r=4;r<16;r+=4){a=MX3(a,C0[r],C0[r+1]);b=MX3(b,C0[r+2],C0[r+3]);a=MX3(a,C1[r],C1[r+1]);b=MX3(b,C1[r+2],C1[r+3]);} \
      float rm=__builtin_fmaxf(a,b); { auto rr=__builtin_amdgcn_permlane32_swap(__float_as_uint(rm),__float_as_uint(rm),false,false); rm=__builtin_fmaxf(__uint_as_float(rr[0]),__uint_as_float(rr[1])); } \
      resc=false; \
      if(__builtin_expect(__any(rm>(float)THRL),0)){ const float dl=__builtin_fmaxf(rm,0.f); mhat+=dl; \
        _Pragma("unroll") for(int r=0;r<16;++r){C0[r]-=dl;C1[r]-=dl;} \
        const float f=__builtin_amdgcn_exp2f(-dl); l_reg*=f; if(hi==0)wsf[r32]=f; resc=true; } } \
    SBAR(); \
    GAPB(o[0]=__builtin_amdgcn_mfma_f32_32x32x16_bf16(PAF(0),VFR(0),o[0],0,0,0), C0,0); \
    GAPB(o[1]=__builtin_amdgcn_mfma_f32_32x32x16_bf16(PAF(0),VFR(4),o[1],0,0,0), C0,4); \
    KRD(GL,0); GAPB(o[0]=__builtin_amdgcn_mfma_f32_32x32x16_bf16(PAF(1),VFR(1),o[0],0,0,0), C0,8); \
    KRD(GL,1); GAPB(o[1]=__builtin_amdgcn_mfma_f32_32x32x16_bf16(PAF(1),VFR(5),o[1],0,0,0), C0,12); \
    KRD(GL,2); GAPB(o[0]=__builtin_amdgcn_mfma_f32_32x32x16_bf16(PAF(2),VFR(2),o[0],0,0,0), C1,0); \
    KRD(GL,3); GAPB(o[1]=__builtin_amdgcn_mfma_f32_32x32x16_bf16(PAF(2),VFR(6),o[1],0,0,0), C1,4); \
    GAPB(o[0]=__builtin_amdgcn_mfma_f32_32x32x16_bf16(PAF(3),VFR(3),o[0],0,0,0), C1,8); \
    GAPB(o[1]=__builtin_amdgcn_mfma_f32_32x32x16_bf16(PAF(3),VFR(7),o[1],0,0,0), C1,12); \
    }while(0)
  int t=1;
  #undef CMASK
  #define CMASK(P0,P1,t) do{}while(0)
  for(;t+5<NT;t+=2){
    STEP(pB0,pB1,pA0,pA1,t,true,true,true);     WAIT_BAR(2); RESC(); ROT();
    STEP(pA0,pA1,pB0,pB1,t+1,true,true,true);   WAIT_BAR(2); RESC(); ROT();
  }
  #undef CMASK
  #define CMASK(P0,P1,t) do{int jb_=(t)-(NT-4); if(jb_>=0)cmask(P0,P1,jb_,qrel,hi);}while(0)
  #define ENDW(tt) do{ if((tt)+3<NT){WAIT_BAR(2);} else if((tt)+2<NT){WAIT_BAR(1);} else {WAIT_BAR(0);} }while(0)
  for(;t+1<NT;t+=2){
    STEP(pB0,pB1,pA0,pA1,t,(t+3<NT),(t+1<NT),(t+1<NT));       ENDW(t);   RESC(); ROT();
    STEP(pA0,pA1,pB0,pB1,t+1,(t+4<NT),(t+2<NT),(t+2<NT));     ENDW(t+1); RESC(); ROT();
  }
  STEP(pB0,pB1,pA0,pA1,NT-1,false,false,false); RESC();
  { float sacc=pB0[0]+pB0[1]; _Pragma("unroll") for(int r=2;r<16;++r)sacc+=pB0[r]; _Pragma("unroll") for(int r=0;r<16;++r)sacc+=pB1[r]; l_reg+=sacc;
    pw0=(u32x4){PKW(pB0,0),PKW(pB0,2),PKW(pB0,4),PKW(pB0,6)};pw1=(u32x4){PKW(pB0,8),PKW(pB0,10),PKW(pB0,12),PKW(pB0,14)};pw2=(u32x4){PKW(pB1,0),PKW(pB1,2),PKW(pB1,4),PKW(pB1,6)};pw3=(u32x4){PKW(pB1,8),PKW(pB1,10),PKW(pB1,12),PKW(pB1,14)};
    SBAR(); pv(o,vb0+sl_cur,PAF(0),PAF(1),PAF(2),PAF(3)); }
  #undef PKW
  #undef PAF
  #undef VFR
  #undef PIN
  #undef MX3
  #undef GAPA
  #undef GAPB
  #undef EX
  #undef VRD
  #undef KRD
  #undef STEP
  #undef ENDW
  {auto rr=__builtin_amdgcn_permlane32_swap(__float_as_uint(l_reg),__float_as_uint(l_reg),false,false);l_reg=__uint_as_float(rr[0])+__uint_as_float(rr[1]);}
  if(hi==0)wsf[32+r32]=l_reg;asm volatile("s_waitcnt lgkmcnt(0)":::"memory");
  float rli[16];
  #pragma unroll
  for(int r=0;r<16;++r)rli[r]=__builtin_amdgcn_rcpf(wsf[32+crow(r,hi)]);
  bf16*Ow=O+(rowbase+q0+wid*QBLK)*DM+h*D;
  { bf16*stg=(bf16*)(shm+LDS_OST)+wid*2048;
    #pragma unroll
    for(int r=0;r<16;++r){const int orow=crow(r,hi);
      #pragma unroll
      for(int d0=0;d0<2;++d0)stg[orow*64+d0*32+r32]=__float2bfloat16(o[d0][r]*rli[r]);}
    asm volatile("s_waitcnt lgkmcnt(0)":::"memory");
    const bf16*Gw=Gt+(rowbase+q0+wid*QBLK)*DM+h*D;
    #pragma unroll
    for(int i=0;i<4;++i){const int row=i*8+(lane>>3),ch=lane&7; u32x4 v=*(const u32x4*)(stg+row*64+ch*8); const u32x4 gg=*(const u32x4*)(Gw+(long)row*DM+ch*8);
      #pragma unroll
      for(int e_=0;e_<4;++e_){ const float lo=__uint_as_float(v[e_]<<16)*__uint_as_float(gg[e_]<<16), hi_=__uint_as_float(v[e_]&0xffff0000u)*__uint_as_float(gg[e_]&0xffff0000u); v[e_]=cvtpk_s(lo,hi_); }
      ATTN_STORE16(Ow+(long)row*DM+ch*8,v);} }
  asm volatile("s_waitcnt lgkmcnt(0)\n\ts_barrier":::"memory");
  #undef CINIT
  #undef DMA_K
  #undef DMA_V
  #undef CMASK
  #undef START
  #undef RESC
  #undef ROT
}
constexpr int ATTN_LDS_BYTES=LDS_BYTES;
struct AttnTensors { const bf16* Q; const bf16* K; const bf16* V; const bf16* G; const float* cum; float TH; bf16* O; };
struct AttnUnit { int bh; int qb; };
struct StaticOrder {
  int vcu, grid;
  __device__ __forceinline__ explicit StaticOrder(int grid_,int block):vcu((grid_%8==0)?(block%8)*(grid_/8)+block/8:block),grid(grid_){}
  __device__ __forceinline__ bool next(int i,AttnUnit&u)const{
    if(grid==256){ if(i>=4)return false; const int s=vcu&3; u.bh=vcu>>2; u.qb=(i==0)?s:(i==1)?7-s:(i==2)?8+s:15-s; return true; }
    const int L=i*grid+vcu; if(L>=BATCH*NHEAD*NQB)return false; u.bh=L/NQB; u.qb=L%NQB; return true; }
};
template<class Sched,int THRL=8> __device__ __forceinline__ void attn_phase(char*lds,const AttnTensors&T,const Sched&S){
  AttnUnit u;
  for(int i=0;S.next(i,u);++i){ attn_unit<THRL>(u.bh/NHEAD,u.bh%NHEAD,u.qb,T.Q,T.K,T.V,T.G,T.cum,T.TH,T.O,lds); }
}
#undef SBAR
#undef WAIT_BAR
}

constexpr size_t MiB = 1u << 20;
constexpr size_t WS_CTL = 0, CTL_ZERO_BYTES = 1 * MiB;
constexpr size_t WS_RSTD = 1 * MiB;
constexpr size_t WS_SSV = 2 * MiB;
constexpr size_t WS_LF = 4 * MiB, WS_CUM = 5 * MiB;
constexpr size_t WS_LA = 6 * MiB, WS_LW = 8 * MiB, WS_LR = 10 * MiB;
constexpr size_t WS_WRT = 12 * MiB;
constexpr size_t WS_WFT = 12 * MiB + 512 * 1024;
constexpr size_t WS_WSM = 13 * MiB;
constexpr size_t WS_WIN = 16 * MiB, WS_WOUT = 24 * MiB, WS_WKVQG = 28 * MiB, WS_WO = 36 * MiB;
constexpr size_t WS_W13 = 40 * MiB, WS_W2 = 104 * MiB;
constexpr size_t WS_XB = 136 * MiB;
constexpr size_t WS_BIG = 168 * MiB;
constexpr size_t WS_GY = 296 * MiB;
constexpr size_t WS_HID = 360 * MiB;
constexpr size_t WS_END = 400 * MiB;
static_assert(WS_HID + (size_t)HID_ROWS * DE * 2 <= WS_END, "ws map");
constexpr int CW_TMO = 0, CW_CODE = 1, CW_BAR = 4096, CW_CNT = 8192;

constexpr int RING_OFF = 0, RING_BYTES = 131072;
constexpr int LDSCTL_OFF = RING_BYTES, MISC_OFF = LDSCTL_OFF + 320;
constexpr int TAB_OFF = LDSCTL_OFF + 512;
constexpr int TABA_OFF = TAB_OFF + 512, TABF_OFF = TABA_OFF + 4096;
constexpr int LDS_BYTES = 147456;
static_assert(TABF_OFF + 4096 <= LDS_BYTES, "LDS map");
constexpr int NWAVES = 8;
constexpr int NPH = 15;

typedef unsigned short bf16;
typedef unsigned v4u __attribute__((ext_vector_type(4)));
typedef unsigned v2u __attribute__((ext_vector_type(2)));
typedef float f32x4 __attribute__((ext_vector_type(4)));
typedef short bf16x8 __attribute__((ext_vector_type(8)));
typedef GAS unsigned gu32;
#define RLX_AGENT __ATOMIC_RELAXED, __HIP_MEMORY_SCOPE_AGENT
#define LDS_WAIT() asm volatile("s_waitcnt lgkmcnt(0)" ::: "memory")
#define VM_WAIT() asm volatile("s_waitcnt vmcnt(0)" ::: "memory")
__device__ __forceinline__ unsigned pk2(float lo, float hi) { return pg8::cvt_pk_bf16(lo, hi); }
__device__ __forceinline__ float bf_lo(unsigned w) { return __uint_as_float(w << 16); }
__device__ __forceinline__ float bf_hi(unsigned w) { return __uint_as_float(w & 0xffff0000u); }

#define XB_TMO      128
#define XB_XCNT(j)  (256  + 64 * (j))
#define XB_XSUB(j)  (1280 + 64 * (j))
#define XB_XGEN(j)  (2304 + 64 * (j))
#define XB_TOP      3328
#define XB_TOPGEN   3392
#define XCD_BAR_WORDS 3456
#define XB_SPIN_CAP (1u << 18)

__device__ __forceinline__ unsigned xb_ld(unsigned* p)              { return __hip_atomic_load(p, __ATOMIC_RELAXED, __HIP_MEMORY_SCOPE_AGENT); }
__device__ __forceinline__ unsigned xb_add(unsigned* p, unsigned v) { return __hip_atomic_fetch_add(p, v, __ATOMIC_RELAXED, __HIP_MEMORY_SCOPE_AGENT); }
__device__ __forceinline__ unsigned xb_xcc_id() { return (unsigned)__builtin_amdgcn_s_getreg((3 << 11) | 20) & 0xFu; }
#define XB_SPIN(cond, bar) do { unsigned _sp = 0; while (cond) { __builtin_amdgcn_s_sleep(1); \
    if ((++_sp & 255u) == 0u) { if (xb_ld(&(bar)[XB_TMO])) break; if (_sp > XB_SPIN_CAP) { atomicAdd(&(bar)[XB_TMO], 1u); break; } } } } while (0)

struct XcdBarrier {
    unsigned* bar; unsigned x;
    volatile LAS unsigned* st;
};

__device__ __forceinline__ XcdBarrier xcd_barrier_post(unsigned* bar, volatile LAS unsigned* st) {
    XcdBarrier b; b.bar = bar; b.x = xb_xcc_id(); b.st = st;
    if (threadIdx.x == 0) (void)xb_add(&bar[XB_XCNT(b.x)], 1u);
    return b;
}
__device__ __forceinline__ void xcd_barrier_complete(unsigned* bar, unsigned x, unsigned& nloc, unsigned& nx) {
    const unsigned G = gridDim.x * gridDim.y * gridDim.z;
    unsigned sum, cnt, mine, sp = 0u;
    for (;;) {
        sum = 0u; cnt = 0u; mine = 0u;
#pragma unroll
        for (unsigned j = 0; j < 16; ++j) { const unsigned c = xb_ld(&bar[XB_XCNT(j)]); sum += c; cnt += (c > 0u) ? 1u : 0u; mine = (j == x) ? c : mine; }
        if (sum == G) break;
        __builtin_amdgcn_s_sleep(1);
        if ((++sp & 255u) == 0u) { if (xb_ld(&bar[XB_TMO])) break; if (sp > XB_SPIN_CAP) { atomicAdd(&bar[XB_TMO], 1u); break; } }
    }
    nloc = mine > 0u ? mine : 1u; nx = cnt > 0u ? cnt : 1u;
}

__device__ __forceinline__ void xcd_barrier(const XcdBarrier& b) {
    asm volatile("s_waitcnt vmcnt(0)" ::: "memory");
    __syncthreads();
    if (threadIdx.x == 0) {
        unsigned* bar = b.bar;
        __builtin_amdgcn_s_waitcnt(0);
        unsigned nloc = b.st[0], nx = b.st[1];
        if (nloc == 0u) { xcd_barrier_complete(bar, b.x, nloc, nx); b.st[0] = nloc; b.st[1] = nx; }
        const unsigned old = xb_add(&bar[XB_XSUB(b.x)], 1u);
        const unsigned gen = old / nloc;
        if (old + 1u == (gen + 1u) * nloc) {
            __builtin_amdgcn_fence(__ATOMIC_RELEASE, "agent");
            asm volatile("s_waitcnt vmcnt(0)" ::: "memory");
            const unsigned og = xb_add(&bar[XB_TOP], 1u);
            const unsigned tg = og / nx;
            if (og + 1u == (tg + 1u) * nx) xb_add(&bar[XB_TOPGEN], 1u);
            else XB_SPIN(xb_ld(&bar[XB_TOPGEN]) == tg, bar);
            __builtin_amdgcn_fence(__ATOMIC_ACQUIRE, "agent");
            xb_add(&bar[XB_XGEN(b.x)], 1u);
            asm volatile("s_waitcnt vmcnt(0)" ::: "memory");
        } else {
            XB_SPIN(xb_ld(&bar[XB_XGEN(b.x)]) == gen, bar);
            __builtin_amdgcn_fence(__ATOMIC_ACQUIRE, "agent");
            asm volatile("s_waitcnt vmcnt(0)" ::: "memory");
        }
    }
    __syncthreads();
}

struct Frame {
    LAS unsigned char* lds;
    volatile LAS unsigned* MISC;
    gu32* ctl;
    int tid, lane, wave, vcu, G;
    const float* in[24]; float* out; unsigned char* ws;
};
__device__ __forceinline__ float wave_sum(float v) {
#pragma unroll
    for (int o = 1; o < 64; o <<= 1) v += __shfl_xor(v, o);
    return v;
}
struct CvtItem { const float* src; const float* gain; bf16* dst; int ldw, K, dbase, dhi; };
__device__ __forceinline__ CvtItem cvt_item(const float* W, int ldw, int K, const float* gain, bf16* WT, int dbase, int dhi, int k0, int n0) {
    CvtItem c; c.src = W + (size_t)k0 * ldw + n0; c.gain = gain ? gain + k0 : nullptr; c.dst = WT + k0; c.ldw = ldw; c.K = K; c.dbase = dbase; c.dhi = dhi; return c; }
struct CvtRegs { f32x4 v[16]; float gl; };
__device__ __forceinline__ void cvt_load(const CvtItem& c, CvtRegs& r, int lane) {
    const int q = lane >> 4, cc = lane & 15; const float* src = c.src + (size_t)(2 * q) * c.ldw + 4 * cc;
#pragma unroll
    for (int i = 0; i < 16; ++i) r.v[i] = __builtin_nontemporal_load((const f32x4*)(src + (size_t)(8 * (i >> 1) + (i & 1)) * c.ldw));
    r.gl = c.gain ? c.gain[lane] : 1.f;
}
__device__ __forceinline__ void cvt_finish(const CvtItem& c, CvtRegs& r, LAS unsigned* scr, int lane) {
    const int q = lane >> 4, cc = lane & 15;
    if (c.gain) {
#pragma unroll
        for (int i = 0; i < 16; ++i) { const float g = __shfl(r.gl, 8 * (i >> 1) + 2 * q + (i & 1)); r.v[i] = r.v[i] * g; } }
#pragma unroll
    for (int m = 0; m < 8; ++m)
#pragma unroll
        for (int j = 0; j < 4; ++j) scr[(4 * cc + j) * 33 + 4 * m + q] = pk2(r.v[2 * m][j], r.v[2 * m + 1][j]);
    LDS_WAIT(); asm volatile("" ::: "memory");
    const int ch = lane & 7;
#pragma unroll
    for (int rr = 0; rr < 8; ++rr) { const int n = (lane >> 3) + 8 * rr; const LAS unsigned* sp = scr + n * 33 + 4 * ch;
        v4u o; o.x = sp[0]; o.y = sp[1]; o.z = sp[2]; o.w = sp[3];
        __builtin_nontemporal_store(o, (GAS v4u*)(c.dst + (size_t)(c.dbase + (n & 31) + (n >> 5) * c.dhi) * c.K + 8 * ch)); }
    LDS_WAIT(); asm volatile("" ::: "memory");
}
__device__ __forceinline__ void tr_item64(const float* W, int ldw, int K, const float* gain, bf16* WT, int dbase, int dhi, LAS unsigned* scr, int k0, int n0, int lane) {
    const CvtItem c = cvt_item(W, ldw, K, gain, WT, dbase, dhi, k0, n0); CvtRegs r; cvt_load(c, r, lane); cvt_finish(c, r, scr, lane);
}
__device__ __forceinline__ int hp_base(int a) { return (a & ~255) + ((a & 255) >> 6) * 32; }
__device__ __forceinline__ CvtItem w13_item(Frame& F, int layer, int it) {
    const float* w1 = F.in[21] + (size_t)layer * NE * D * DE; const float* w3 = F.in[22] + (size_t)layer * NE * D * DE; const float* mg = F.in[16] + layer * D; bf16* W13 = (bf16*)(F.ws + WS_W13);
    const int e = it >> 8, which = (it >> 7) & 1, sub = it & 127, kb = sub >> 3, nb = sub & 7, c0 = 64 * nb; const int dst = e * 1024 + 256 * (c0 >> 7) + (c0 & 127) + which * 128;
    return cvt_item((which ? w3 : w1) + (size_t)e * D * DE, DE, D, mg, W13, dst, 32, 64 * kb, c0);
}
__device__ __forceinline__ CvtItem w2_item(Frame& F, int layer, int it) {
    const float* w2 = F.in[23] + (size_t)layer * NE * DE * D; bf16* W2 = (bf16*)(F.ws + WS_W2);
    const int e = it >> 7, sub = it & 127, kb = sub >> 4, nb = sub & 15; return cvt_item(w2 + (size_t)e * DE * D, D, DE, nullptr, W2, e * 1024 + 64 * nb, 32, 64 * kb, 64 * nb);
}
__device__ __forceinline__ void cvt_w13_item(Frame& F, int layer, int it, LAS unsigned* scr) { const CvtItem c = w13_item(F, layer, it); CvtRegs r; cvt_load(c, r, F.lane); cvt_finish(c, r, scr, F.lane); }
__device__ __forceinline__ void cvt_w2_item(Frame& F, int layer, int it, LAS unsigned* scr) { const CvtItem c = w2_item(F, layer, it); CvtRegs r; cvt_load(c, r, F.lane); cvt_finish(c, r, scr, F.lane); }
template <bool W2> __device__ __forceinline__ void cvt_slice(Frame& F, int layer, int lo, int hi, int w, int nw) {
    LAS unsigned* scr = (LAS unsigned*)(F.lds + RING_OFF + F.wave * 16384);
    int it = lo + w; if (it >= hi) return;
    CvtItem c = W2 ? w2_item(F, layer, it) : w13_item(F, layer, it); CvtRegs r; cvt_load(c, r, F.lane);
    for (;;) { const int nx = it + nw; const bool more = nx < hi; CvtItem cn = c; CvtRegs rn;
        if (more) { cn = W2 ? w2_item(F, layer, nx) : w13_item(F, layer, nx); cvt_load(cn, rn, F.lane); }
        cvt_finish(c, r, scr, F.lane);
        if (!more) break;
        c = cn; r = rn; it = nx; }
}
__device__ __forceinline__ void p0_prologue(Frame& F) {
    LAS unsigned* scr = (LAS unsigned*)(F.lds + RING_OFF + F.wave * 16384);
    const int gw = F.vcu * NWAVES + F.wave, NGW = F.G * NWAVES;
    bf16* WIN = (bf16*)(F.ws + WS_WIN); bf16* WOUT = (bf16*)(F.ws + WS_WOUT); bf16* WKVQG = (bf16*)(F.ws + WS_WKVQG); bf16* WO = (bf16*)(F.ws + WS_WO);
    { float* rstd = (float*)(F.ws + WS_RSTD); bf16* XB = (bf16*)(F.ws + WS_XB);
      for (int m = 2 * gw; m < T; m += 2 * NGW) { const GAS f32x4* xr = (const GAS f32x4*)(F.in[0] + (size_t)m * D) + F.lane; f32x4 v[8]; float s0 = 0.f, s1 = 0.f;
#pragma unroll
          for (int j = 0; j < 8; ++j) v[j] = xr[64 * j];
#pragma unroll
          for (int j = 0; j < 4; ++j) { s0 += pg8::sq4(v[j]); s1 += pg8::sq4(v[4 + j]); }
          s0 = wave_sum(s0); s1 = wave_sum(s1); if (F.lane == 0) { rstd[m] = 1.0f / sqrtf(s0 * (1.f / D) + EPS); rstd[m + 1] = 1.0f / sqrtf(s1 * (1.f / D) + EPS); }
          GAS v2u* o8 = (GAS v2u*)(XB + (size_t)m * D) + F.lane;
#pragma unroll
          for (int j = 0; j < 8; ++j) o8[64 * j] = (v2u){pk2(v[j][0], v[j][1]), pk2(v[j][2], v[j][3])}; } }
    constexpr int I1 = 16 * 64, I2 = 32 * 16, I3 = 16 * 16, IDENSE = I1 + I2 + 5 * I3;
    const int nitems = IDENSE;
    for (int it = gw; it < nitems; it += NGW) {
        int r = it;
        if (r < I1) { const int kb = r >> 6, nb = r & 63; tr_item64(F.in[2], ZW, D, F.in[1], WIN, 64 * nb, 32, scr, 64 * kb, 64 * nb, F.lane); continue; } r -= I1;
        if (r < I2) { const int kb = r >> 4, nb = r & 15; tr_item64(F.in[7], D, SW, nullptr, WOUT, 64 * nb, 32, scr, 64 * kb, 64 * nb, F.lane); continue; } r -= I2;
        const int job = r / I3, rr = r % I3, kb = rr >> 4, nb = rr & 15;
        if (job == 0) tr_item64(F.in[9], KVW, D, F.in[8], WKVQG, hp_base(64 * nb), 128, scr, 64 * kb, 64 * nb, F.lane);
        else if (job == 1) tr_item64(F.in[9], KVW, D, F.in[8], WKVQG, 1024 + hp_base(64 * nb), 128, scr, 64 * kb, 1024 + 64 * nb, F.lane);
        else if (job == 2) tr_item64(F.in[13], 2 * D, D, F.in[12], WKVQG, 2048 + hp_base(64 * nb), 128, scr, 64 * kb, 64 * nb, F.lane);
        else if (job == 3) tr_item64(F.in[13], 2 * D, D, F.in[12], WKVQG, 3072 + hp_base(64 * nb), 128, scr, 64 * kb, 1024 + 64 * nb, F.lane);
        else tr_item64(F.in[15], D, D, nullptr, WO, 64 * nb, 32, scr, 64 * kb, 64 * nb, F.lane);
    }
    { const int gt = F.vcu * (NWAVES * 64) + F.tid, NGT = F.G * NWAVES * 64;
      float* WFT = (float*)(F.ws + WS_WFT); bf16* WRH = (bf16*)(F.ws + WS_WRT); bf16* WSM = (bf16*)(F.ws + WS_WSM);
      for (int i = gt; i < H * D; i += NGT) { const int h = i >> 10, k = i & 1023; WFT[i] = F.in[9][(size_t)k * KVW + 2 * D + h] * F.in[8][k]; }
      for (int i = gt; i < 2 * 48 * D; i += NGT) { const int l = i / (48 * D), j = (i >> 10) % 48, k = i & 1023; const float g = F.in[16][l * D + k];
          float v = 0.f; if (j < 32) v = F.in[19][((size_t)l * D + k) * NE + j] * g; else if (j < 36) v = F.in[17][((size_t)l * D + k) * NG + (j - 32)] * g;
          const unsigned h = pk2(v, 0.f) & 0xffffu; const unsigned lo = pk2(v - __uint_as_float(h << 16), 0.f) & 0xffffu; WRH[i] = (bf16)h; WRH[2 * 48 * D + i] = (bf16)lo; }
      for (int i = gt; i < 8 * 128 * 128; i += NGT) { const int t = (i >> 7) & 127, s = i & 127; const float v = (t < 64 && s >= 64) ? 0.f : F.in[5][i]; WSM[i] = (bf16)(pk2(v, 0.f) & 0xffffu); } }
}
constexpr int SG_WSTR = 272, SG_VSTR = 524, SG_OSTR = 528;
constexpr int SG_WOFF = 0, SG_VOFF = 128 * SG_WSTR, SG_ROFF = SG_VOFF + 128 * SG_OSTR;
static_assert(SG_ROFF + 1024 <= RING_BYTES, "sgu LDS");
__device__ __forceinline__ void sgu_phase(Frame& F) {
    const bf16* Z = (const bf16*)(F.ws + WS_BIG); bf16* GY = (bf16*)(F.ws + WS_GY); const bf16* WSM = (const bf16*)(F.ws + WS_WSM); const float* ssv = (const float*)(F.ws + WS_SSV);
    const float* gvn = F.in[4]; const float* bs = F.in[6];
    LAS unsigned char* L = F.lds + RING_OFF; LAS float* rs = (LAS float*)(L + SG_ROFF);
    const int tid = F.tid, lane = F.lane, w = F.wave, n15 = lane & 15, kq = lane >> 4;
    const int NU = (T / 128) * 8;
    int gloaded = -1, u = F.vcu, buf = 0;
    if (u >= NU) return;
    v4u vraw[8]; f32x4 sp[2];
    { const int g = u & 7, nb = u >> 3;
#pragma unroll
      for (int j = 0; j < 8; ++j) { const int idx = tid + 512 * j, s = idx >> 5, cc = idx & 31; vraw[j] = *(const v4u*)(Z + (size_t)(nb * 128 + s) * ZW + SW + 256 * g + 8 * cc); }
      { const float* p = ssv + (size_t)(nb * 128 + (tid >> 2)) * 32 + 8 * (tid & 3); const f32x4 a = *(const f32x4*)p, b = *(const f32x4*)(p + 4);
          float sm = ((a[0] + a[1]) + (a[2] + a[3])) + ((b[0] + b[1]) + (b[2] + b[3])); sm += __shfl_xor(sm, 1); sm += __shfl_xor(sm, 2);
          if ((tid & 3) == 0) rs[tid >> 2] = 1.0f / sqrtf(sm * (1.f / SW) + EPS); } }
    for (;;) {
        const int g = u & 7, nb = u >> 3, un = u + F.G; const bool more = un < NU;
        if (g != gloaded) {
#pragma unroll
            for (int j = 0; j < 4; ++j) { const int idx = tid + 512 * j, row = idx >> 4, cc = idx & 15;
                *(LAS v4u*)(L + SG_WOFF + row * SG_WSTR + cc * 16) = *(const v4u*)(WSM + (size_t)g * 16384 + row * 128 + cc * 8); }
            gloaded = g; }
        __syncthreads();
#pragma unroll
        for (int j = 0; j < 8; ++j) { const int idx = tid + 512 * j, s = idx >> 5, cc = idx & 31; const v4u raw = vraw[j]; const float r = rs[buf * 128 + s];
            LAS unsigned* dst = (LAS unsigned*)(L + SG_VOFF + s * SG_VSTR + cc * 16);
            dst[0] = pk2(bf_lo(raw.x) * r, bf_hi(raw.x) * r); dst[1] = pk2(bf_lo(raw.y) * r, bf_hi(raw.y) * r); dst[2] = pk2(bf_lo(raw.z) * r, bf_hi(raw.z) * r); dst[3] = pk2(bf_lo(raw.w) * r, bf_hi(raw.w) * r); }
        v4u uu[8];
#pragma unroll
        for (int j = 0; j < 8; ++j) { const int idx = tid + 512 * j; uu[j] = *(const v4u*)(Z + ((size_t)nb * 128 + (idx >> 5)) * ZW + 256 * g + 8 * (idx & 31)); }
        if (more) { const int g2 = un & 7, nb2 = un >> 3;
#pragma unroll
            for (int j = 0; j < 8; ++j) { const int idx = tid + 512 * j, s = idx >> 5, cc = idx & 31; vraw[j] = *(const v4u*)(Z + (size_t)(nb2 * 128 + s) * ZW + SW + 256 * g2 + 8 * cc); }
            { const float* p = ssv + (size_t)(nb2 * 128 + (tid >> 2)) * 32 + 8 * (tid & 3); sp[0] = *(const f32x4*)p; sp[1] = *(const f32x4*)(p + 4); } }
        __syncthreads();
        f32x4 acc[8][2];
#pragma unroll
        for (int mt = 0; mt < 8; ++mt) { acc[mt][0] = (f32x4){0.f, 0.f, 0.f, 0.f}; acc[mt][1] = (f32x4){0.f, 0.f, 0.f, 0.f}; }
#pragma unroll
        for (int ks = 0; ks < 4; ++ks) {
            bf16x8 vf[2];
#pragma unroll
            for (int nt = 0; nt < 2; ++nt) { const LAS unsigned short* vp = (const LAS unsigned short*)(L + SG_VOFF) + (32 * ks + 8 * kq) * (SG_VSTR / 2) + 32 * w + 16 * nt + n15;
#pragma unroll
                for (int j = 0; j < 8; ++j) vf[nt][j] = (short)vp[j * (SG_VSTR / 2)]; }
#pragma unroll
            for (int mt = 0; mt < 8; ++mt) if (mt >= 4 || ks < 2) {
                const bf16x8 wf = *(const LAS bf16x8*)(L + SG_WOFF + (16 * mt + n15) * SG_WSTR + (32 * ks + 8 * kq) * 2);
                acc[mt][0] = __builtin_amdgcn_mfma_f32_16x16x32_bf16(vf[0], wf, acc[mt][0], 0, 0, 0); acc[mt][1] = __builtin_amdgcn_mfma_f32_16x16x32_bf16(vf[1], wf, acc[mt][1], 0, 0, 0); }
        }
        __syncthreads();
        { f32x4 gv[2];
#pragma unroll
          for (int nt = 0; nt < 2; ++nt) gv[nt] = *(const f32x4*)(gvn + 256 * g + 32 * w + 16 * nt + 4 * kq);
#pragma unroll
          for (int mt = 0; mt < 8; ++mt) { const int t = 16 * mt + n15; const float bst = bs[g * 128 + t];
#pragma unroll
            for (int nt = 0; nt < 2; ++nt) { const f32x4 a = acc[mt][nt];
                *(LAS v2u*)(L + SG_VOFF + t * SG_OSTR + (32 * w + 16 * nt + 4 * kq) * 2) = (v2u){pk2(gv[nt][0] * a[0] + bst, gv[nt][1] * a[1] + bst), pk2(gv[nt][2] * a[2] + bst, gv[nt][3] * a[3] + bst)}; } } }
        __syncthreads();
#pragma unroll
        for (int j = 0; j < 8; ++j) { const int idx = tid + 512 * j, t = idx >> 5, cc = idx & 31; const v4u in = *(const LAS v4u*)(L + SG_VOFF + t * SG_OSTR + cc * 16); const v4u u4 = uu[j];
            v4u o; o.x = pk2(bf_lo(u4.x) * bf_lo(in.x), bf_hi(u4.x) * bf_hi(in.x)); o.y = pk2(bf_lo(u4.y) * bf_lo(in.y), bf_hi(u4.y) * bf_hi(in.y));
            o.z = pk2(bf_lo(u4.z) * bf_lo(in.z), bf_hi(u4.z) * bf_hi(in.z)); o.w = pk2(bf_lo(u4.w) * bf_lo(in.w), bf_hi(u4.w) * bf_hi(in.w));
            *(v4u*)(GY + ((size_t)nb * 128 + t) * SW + 256 * g + 8 * cc) = o; }
        if (!more) break;
        { float sm = ((sp[0][0] + sp[0][1]) + (sp[0][2] + sp[0][3])) + ((sp[1][0] + sp[1][1]) + (sp[1][2] + sp[1][3])); sm += __shfl_xor(sm, 1); sm += __shfl_xor(sm, 2);
            if ((tid & 3) == 0) rs[(buf ^ 1) * 128 + (tid >> 2)] = 1.0f / sqrtf(sm * (1.f / SW) + EPS); }
        buf ^= 1; u = un;
    }
}
__device__ __forceinline__ void route_phase(Frame& F, int layer) {
    const float* X = F.out; const bf16* WRH = (const bf16*)(F.ws + WS_WRT) + (size_t)layer * 48 * D; const bf16* WRL = WRH + 2 * 48 * D;
    const float* bg = F.in[18] + layer * NG; const float* be = F.in[20] + layer * NE;
    int* LA = (int*)(F.ws + WS_LA); float* LW = (float*)(F.ws + WS_LW); float* LR = (float*)(F.ws + WS_LR);
    LAS unsigned char* L = F.lds + RING_OFF;
    LAS float* lg = (LAS float*)L + F.wave * (16 * 48);
    LAS int* lcnt = (LAS int*)(L + 16384); LAS int* lbase = lcnt + 32; LAS int* sel_e = lcnt + 64; LAS int* sel_rk = lcnt + 192; LAS float* sel_w = (LAS float*)(lcnt + 320); LAS float* sel_r = (LAS float*)(lcnt + 448);
    const int tid = F.tid, lane = F.lane, m = lane & 15, kq = lane >> 4;
    for (int grp = F.vcu; grp < T / 64; grp += F.G) {
        if (tid < 32) lcnt[tid] = 0;
        __syncthreads();
        const int tile = F.wave & 3, kh = F.wave >> 2, r0 = grp * 64 + tile * 16;
        f32x4 a0 = (f32x4){0.f, 0.f, 0.f, 0.f}, a1 = a0, a2 = a0; float ss = 0.f;
        {
            const float* xr = X + (size_t)(r0 + m) * D + kh * 512 + 8 * kq; const bf16* wh = WRH + (size_t)m * D + kh * 512 + 8 * kq; const bf16* wl = WRL + (size_t)m * D + kh * 512 + 8 * kq;
#pragma unroll 4
            for (int st = 0; st < 16; ++st) { const f32x4 x0 = *(const f32x4*)(xr + 32 * st), x1 = *(const f32x4*)(xr + 32 * st + 4);
                ss += pg8::sq4(x0) + pg8::sq4(x1);
                v4u hv, lv; hv.x = pk2(x0[0], x0[1]); hv.y = pk2(x0[2], x0[3]); hv.z = pk2(x1[0], x1[1]); hv.w = pk2(x1[2], x1[3]);
                lv.x = pk2(x0[0] - bf_lo(hv.x), x0[1] - bf_hi(hv.x)); lv.y = pk2(x0[2] - bf_lo(hv.y), x0[3] - bf_hi(hv.y)); lv.z = pk2(x1[0] - bf_lo(hv.z), x1[1] - bf_hi(hv.z)); lv.w = pk2(x1[2] - bf_lo(hv.w), x1[3] - bf_hi(hv.w));
                const bf16x8 xh = __builtin_bit_cast(bf16x8, hv), xl = __builtin_bit_cast(bf16x8, lv);
#pragma unroll
                for (int nt = 0; nt < 3; ++nt) { const bf16x8 bh = *(const bf16x8*)(wh + (size_t)nt * 16 * D + 32 * st), bl = *(const bf16x8*)(wl + (size_t)nt * 16 * D + 32 * st);
                    f32x4& a = nt == 0 ? a0 : (nt == 1 ? a1 : a2);
                    a = __builtin_amdgcn_mfma_f32_16x16x32_bf16(xl, bh, a, 0, 0, 0); a = __builtin_amdgcn_mfma_f32_16x16x32_bf16(xh, bl, a, 0, 0, 0); a = __builtin_amdgcn_mfma_f32_16x16x32_bf16(xh, bh, a, 0, 0, 0); } }
            ss += __shfl_xor(ss, 16); ss += __shfl_xor(ss, 32);
            LAS f32x4* px = (LAS f32x4*)(L + 32768) + tile * 192 + lane; LAS float* ps = (LAS float*)(L + 32768 + 12288) + tile * 64 + lane;
            if (kh == 1) { px[0] = a0; px[64] = a1; px[128] = a2; ps[0] = ss; }
            __syncthreads();
            if (kh == 0) { a0 = a0 + px[0]; a1 = a1 + px[64]; a2 = a2 + px[128]; ss += ps[0]; }
        }
        if (F.wave < 4) {
            const float rstd = 1.0f / sqrtf(ss * (1.f / D) + EPS);
#pragma unroll
            for (int i = 0; i < 4; ++i) { const float rr = __shfl(rstd, 4 * kq + i); LAS float* p = lg + (4 * kq + i) * 48 + m; p[0] = a0[i] * rr; p[16] = a1[i] * rr; p[32] = a2[i] * rr; }
            LDS_WAIT(); asm volatile("" ::: "memory");
            if (lane < 16) {
                const LAS float* lr = lg + lane * 48;
                float gl[4];
#pragma unroll
                for (int j = 0; j < 4; ++j) gl[j] = lr[32 + j] + bg[j];
                int gs = 0; float gm = gl[0];
#pragma unroll
                for (int j = 1; j < 4; ++j) if (gl[j] > gm) { gm = gl[j]; gs = j; }
                float gsum = 0.f;
#pragma unroll
                for (int j = 0; j < 4; ++j) gsum += __expf(gl[j] - gm);
                const float gw = 1.f / gsum;
                float el[8];
#pragma unroll
                for (int j = 0; j < 8; ++j) el[j] = lr[gs * 8 + j] + be[gs * 8 + j];
                int i0 = 0; float v0 = el[0];
#pragma unroll
                for (int j = 1; j < 8; ++j) if (el[j] > v0) { v0 = el[j]; i0 = j; }
                int i1 = -1; float v1 = -INFINITY;
#pragma unroll
                for (int j = 0; j < 8; ++j) if (j != i0 && el[j] > v1) { v1 = el[j]; i1 = j; }
                const float p1 = __expf(v1 - v0), w0_ = 1.f / (1.f + p1), w1_ = p1 * w0_;
                const int e0 = gs * 8 + i0, e1 = gs * 8 + i1, q = F.wave * 16 + lane;
                sel_e[2 * q] = e0; sel_e[2 * q + 1] = e1; sel_w[2 * q] = gw * w0_; sel_w[2 * q + 1] = gw * w1_; sel_r[q] = rstd;
                sel_rk[2 * q] = __hip_atomic_fetch_add(lcnt + e0, 1, __ATOMIC_RELAXED, __HIP_MEMORY_SCOPE_WORKGROUP);
                sel_rk[2 * q + 1] = __hip_atomic_fetch_add(lcnt + e1, 1, __ATOMIC_RELAXED, __HIP_MEMORY_SCOPE_WORKGROUP);
            }
        }
        __syncthreads();
        if (tid < 32) { const int c = lcnt[tid]; lbase[tid] = c ? (int)__hip_atomic_fetch_add(F.ctl + CW_CNT + (layer * 32 + tid) * 64, (unsigned)c, RLX_AGENT) : 0; }
        __syncthreads();
        if (tid < 128) { const int e = sel_e[tid]; const int pos = lbase[e] + sel_rk[tid]; const size_t o = (size_t)e * LCAP + pos;
            LA[o] = 2 * (grp * 64 + (tid >> 1)) + (tid & 1); LW[o] = sel_w[tid]; LR[o] = sel_r[tid >> 1]; }
        __syncthreads();
    }
}
template <bool G1> __device__ __forceinline__ int moe_setup(Frame& F, int layer, int Geff, int ceff) {
    LAS int* mt = (LAS int*)(F.lds + TAB_OFF); LAS int* hb = mt + 32; LAS int* cl = mt + 64; LAS int* tot = mt + 96;
    LAS int* tabA = (LAS int*)(F.lds + TABA_OFF); LAS float* tabF = (LAS float*)(F.lds + TABF_OFF);
    const int* LA = (const int*)(F.ws + WS_LA); const float* LW = (const float*)(F.ws + WS_LW); const float* LR = (const float*)(F.ws + WS_LR);
    if (F.tid < 64) { const int l = F.tid & 31; const int c = (int)__hip_atomic_load(F.ctl + CW_CNT + (layer * 32 + l) * 64, RLX_AGENT); const int m = (c + 255) >> 8; int incl = m;
#pragma unroll
        for (int o = 1; o < 32; o <<= 1) { const int v = __shfl_up(incl, o, 32); if (l >= o) incl += v; }
        if (F.tid < 32) { cl[l] = c; mt[l] = m; hb[l] = 256 * (incl - m); if (l == 31) tot[0] = 4 * incl; } }
    __syncthreads();
    const int total = tot[0];
    if (F.tid < 4) { int Lx = F.tid * Geff + ceff, e = 0, pm = 0, ok = 0;
        if (Lx < total) { for (; e < 31; ++e) { const int ue = 4 * mt[e]; if (Lx < ue) break; Lx -= ue; } const int m = mt[e], pn = Lx / m; pm = Lx - pn * m; ok = 1; }
        tot[4 + 4 * F.tid] = e; tot[5 + 4 * F.tid] = pm; tot[6 + 4 * F.tid] = ok; }
    __syncthreads();
    for (int idx = F.tid; idx < 4 * 256; idx += NWAVES * 64) {
        const int slot = idx >> 8, r = idx & 255, e = tot[4 + 4 * slot], pos = 256 * tot[5 + 4 * slot] + r; int a = G1 ? 0 : -1; float f = 0.f;
        if (tot[6 + 4 * slot] && pos < cl[e]) { const size_t o = (size_t)e * LCAP + pos; const int av = LA[o]; const float fv = G1 ? LR[o] : LW[o]; a = G1 ? (av >> 1) : av; f = fv; }
        tabA[idx] = a; tabF[idx] = f;
    }
    __syncthreads();
    return total;
}
__device__ __forceinline__ void combine0_phase(Frame& F) {
    const bf16* Y2 = (const bf16*)(F.ws + WS_GY); bf16* XB = (bf16*)(F.ws + WS_XB); float* rstd = (float*)(F.ws + WS_RSTD); float* LF = (float*)(F.ws + WS_LF);
    const float* WFT = (const float*)(F.ws + WS_WFT); const float* bfv = F.in[10];
    LAS float* rsl = (LAS float*)(F.lds + RING_OFF); LAS f32x4* cf = (LAS f32x4*)(F.lds + RING_OFF + 1024);
    const int lane = F.lane, m = lane & 15, kq = lane >> 4, tile = F.wave & 3, kh = F.wave >> 2;
    for (int grp = F.vcu; grp < T / 64; grp += F.G) {
#pragma unroll 2
        for (int i = 0; i < 8; ++i) { const int row = grp * 64 + F.wave * 8 + i;
            GAS f32x4* xr = (GAS f32x4*)(F.out + (size_t)row * D) + lane; const GAS v2u* ya = (const GAS v2u*)(Y2 + (size_t)(2 * row) * D) + lane; const GAS v2u* yb = ya + D / 4; GAS v2u* xb = (GAS v2u*)(XB + (size_t)row * D) + lane;
            float ss = 0.f;
#pragma unroll
            for (int j = 0; j < 4; ++j) { const f32x4 xv = xr[64 * j]; const v2u a = ya[64 * j], b = yb[64 * j];
                const f32x4 x2 = (f32x4){xv[0] + bf_lo(a.x) + bf_lo(b.x), xv[1] + bf_hi(a.x) + bf_hi(b.x), xv[2] + bf_lo(a.y) + bf_lo(b.y), xv[3] + bf_hi(a.y) + bf_hi(b.y)};
                xr[64 * j] = x2; xb[64 * j] = (v2u){pk2(x2[0], x2[1]), pk2(x2[2], x2[3])}; ss += pg8::sq4(x2); }
            ss = wave_sum(ss); const float rs = 1.0f / sqrtf(ss * (1.f / D) + EPS);
            if (lane == 0) { rstd[row] = rs; rsl[F.wave * 8 + i] = rs; } }
        VM_WAIT(); __syncthreads();
        const int r0 = grp * 64 + tile * 16;
        const float* xr = F.out + (size_t)(r0 + m) * D + kh * 512 + 4 * kq; const float* wf = WFT + (size_t)m * D + kh * 512 + 4 * kq;
        f32x4 fa = (f32x4){0.f, 0.f, 0.f, 0.f};
#pragma unroll 8
        for (int J = 0; J < 32; ++J) { const f32x4 xv = *(const f32x4*)(xr + 16 * J); const f32x4 wv = *(const f32x4*)(wf + 16 * J);
#pragma unroll
            for (int i = 0; i < 4; ++i) fa = __builtin_amdgcn_mfma_f32_16x16x4f32(xv[i], wv[i], fa, 0, 0, 0); }
        if (kh == 1) cf[tile * 64 + lane] = fa;
        __syncthreads();
        if (kh == 0) { fa = fa + cf[tile * 64 + lane];
            f32x4 o; const float bb = bfv[m];
#pragma unroll
            for (int i = 0; i < 4; ++i) { const float f = fa[i] * rsl[tile * 16 + 4 * kq + i] + bb; o[i] = fminf(f, 0.f) - log1pf(__expf(-fabsf(f))); }
            const int b = r0 / S, t0 = r0 % S; *(f32x4*)(LF + ((size_t)(b * H + m)) * S + t0 + 4 * kq) = o; }
        __syncthreads();
    }
}
__device__ __forceinline__ void cumsum_seq(Frame& F, int seq) {
    const float* lf = (const float*)(F.ws + WS_LF) + (size_t)seq * S; float* cum = (float*)(F.ws + WS_CUM) + (size_t)seq * S;
    LAS float* wt = (LAS float*)(F.lds + RING_OFF);
    const f32x4 a = *(const f32x4*)(lf + 8 * F.tid), b = *(const f32x4*)(lf + 8 * F.tid + 4);
    float p[8]; p[0] = a[0]; p[1] = p[0] + a[1]; p[2] = p[1] + a[2]; p[3] = p[2] + a[3]; p[4] = p[3] + b[0]; p[5] = p[4] + b[1]; p[6] = p[5] + b[2]; p[7] = p[6] + b[3];
    float incl = p[7];
#pragma unroll
    for (int o = 1; o < 64; o <<= 1) { const float v = __shfl_up(incl, o); if (F.lane >= o) incl += v; }
    if (F.lane == 63) wt[F.wave] = incl;
    __syncthreads();
    float base = incl - p[7];
    for (int w = 0; w < F.wave; ++w) base += wt[w];
    *(f32x4*)(cum + 8 * F.tid) = (f32x4){p[0] + base, p[1] + base, p[2] + base, p[3] + base}; *(f32x4*)(cum + 8 * F.tid + 4) = (f32x4){p[4] + base, p[5] + base, p[6] + base, p[7] + base};
    __syncthreads();
}
__device__ __forceinline__ void final_phase(Frame& F) {
    const bf16* Y2 = (const bf16*)(F.ws + WS_GY); const int gw = F.vcu * NWAVES + F.wave, NGW = F.G * NWAVES;
    for (int m = gw; m < T; m += NGW) { GAS f32x4* xr = (GAS f32x4*)(F.out + (size_t)m * D) + F.lane; const GAS v2u* ya = (const GAS v2u*)(Y2 + (size_t)(2 * m) * D) + F.lane; const GAS v2u* yb = ya + D / 4;
#pragma unroll
        for (int j = 0; j < 4; ++j) { const f32x4 xv = xr[64 * j]; const v2u a = ya[64 * j], b = yb[64 * j];
            xr[64 * j] = (f32x4){xv[0] + bf_lo(a.x) + bf_lo(b.x), xv[1] + bf_hi(a.x) + bf_hi(b.x), xv[2] + bf_lo(a.y) + bf_lo(b.y), xv[3] + bf_hi(a.y) + bf_hi(b.y)}; } }
}

struct Args { const float* in[24]; float* out; unsigned char* ws; int ph_lo, ph_hi; };
__global__ void __launch_bounds__(NWAVES * 64, 2) fwd(Args args) {
    extern __shared__ __attribute__((aligned(16))) unsigned char lds[];
    Frame F;
    F.lds = (LAS unsigned char*)lds; F.MISC = (volatile LAS unsigned*)(F.lds + MISC_OFF);
    F.tid = threadIdx.x; F.lane = F.tid & 63; F.wave = __builtin_amdgcn_readfirstlane(F.tid >> 6);
    F.G = gridDim.x; { const int bx = blockIdx.x; F.vcu = (F.G % 8 == 0) ? (bx % 8) * (F.G / 8) + bx / 8 : bx; }
    F.ws = args.ws; F.ctl = (gu32*)(args.ws + WS_CTL); F.out = args.out;
#pragma unroll
    for (int i = 0; i < 24; ++i) F.in[i] = args.in[i];
    for (int u = F.tid; u < (TAB_OFF - LDSCTL_OFF) / 4; u += NWAVES * 64) ((LAS unsigned*)(F.lds + LDSCTL_OFF))[u] = 0u;
    __syncthreads();
#if MK_PER_PHASE
#define GRID_BAR() do { } while (0)
#else
    XcdBarrier bar = xcd_barrier_post((unsigned*)(F.ctl + CW_BAR), F.MISC + 8);
#define GRID_BAR() xcd_barrier(bar)
#endif
    const int lo = args.ph_lo, hi = args.ph_hi;
#define IN(k) (lo <= (k) && (k) < hi)
#define SEAM(k) do { if (IN(k) && IN((k) + 1)) GRID_BAR(); } while (0)
#define PH_BEGIN(k) const unsigned long long t0_##k = ((TIMEMASK >> (k)) & 1) ? __builtin_amdgcn_s_memrealtime() : 0ull
#define PH_END(k) do { if ((TIMEMASK >> (k)) & 1) { const unsigned long long t1_ = __builtin_amdgcn_s_memrealtime(); while (__builtin_amdgcn_s_memrealtime() - t1_ < t1_ - t0_##k) __builtin_amdgcn_s_sleep(8); } } while (0)
    bf16* XB = (bf16*)(F.ws + WS_XB); float* RSTD = (float*)(F.ws + WS_RSTD);
    bf16* ZB = (bf16*)(F.ws + WS_BIG); bf16* GY = (bf16*)(F.ws + WS_GY); bf16* HID = (bf16*)(F.ws + WS_HID);
    bf16* KB = ZB; bf16* VB = ZB + (size_t)T * D; bf16* QB = ZB + (size_t)2 * T * D; bf16* GB = ZB + (size_t)3 * T * D;
    LAS int* mt = (LAS int*)(F.lds + TAB_OFF); LAS int* hb = mt + 32; LAS int* tabA = (LAS int*)(F.lds + TABA_OFF); LAS float* tabF = (LAS float*)(F.lds + TABF_OFF);

    PH_BEGIN(0); if (IN(0)) { p0_prologue(F); } PH_END(0); SEAM(0);
    const int gw_all = F.vcu * NWAVES + F.wave, nw_all = F.G * NWAVES;
    const bool cvt_first = (F.vcu & 1) != 0;
    PH_BEGIN(1); if (IN(1)) { if (cvt_first) { cvt_slice<false>(F, 0, 0, NE * 256, gw_all, nw_all); __syncthreads(); }
        pg8::DenseOrder So; So.init(T, ZW, F.G, (int)blockIdx.x); pg8::EpiIn E{ZB, RSTD, F.in[3], (float*)(F.ws + WS_SSV)};
        pg8::gemm_phase<pg8::EpiIn, pg8::DenseOrder, true, true>(F.lds + RING_OFF, XB, (const bf16*)(F.ws + WS_WIN), D, So, E);
        if (!cvt_first) cvt_slice<false>(F, 0, 0, NE * 256, gw_all, nw_all); } PH_END(1); SEAM(1);
    PH_BEGIN(2); if (IN(2)) { sgu_phase(F); } PH_END(2); SEAM(2);
    PH_BEGIN(3); if (IN(3)) { pg8::DenseOrder So; So.init(T, D, F.G, (int)blockIdx.x); pg8::EpiRes E{F.in[0], F.out, XB};
        pg8::gemm_phase<pg8::EpiRes, pg8::DenseOrder, true, true>(F.lds + RING_OFF, GY, (const bf16*)(F.ws + WS_WOUT), SW, So, E); } PH_END(3); SEAM(3);
    PH_BEGIN(4); if (IN(4)) { route_phase(F, 0); } PH_END(4); SEAM(4);
#define SHADOW_CVT(W2, layer, lo, hi) do { const int busy = total - 2 * F.G; int ni = F.G - (busy > 0 ? busy : 0), ci = F.vcu - (busy > 0 ? busy : 0); if (ni <= 0) { ni = F.G; ci = F.vcu; } \
        if (ci >= 0) cvt_slice<W2>(F, layer, lo, hi, ci * NWAVES + F.wave, ni * NWAVES); } while (0)
    PH_BEGIN(5); if (IN(5)) { const int total = moe_setup<true>(F, 0, F.G, F.vcu); pg8::MoeOrder<true> So{mt, hb, tabA, total, F.G, F.vcu}; pg8::EpiMoe1 E{HID, tabF};
        pg8::gemm_phase<pg8::EpiMoe1, pg8::MoeOrder<true>, true, true>(F.lds + RING_OFF, XB, (const bf16*)(F.ws + WS_W13), D, So, E);
        SHADOW_CVT(true, 0, 0, NE * 128); } PH_END(5); SEAM(5);
    PH_BEGIN(6); if (IN(6)) { const int total = moe_setup<false>(F, 0, F.G, F.vcu); pg8::MoeOrder<false> So{mt, hb, tabA, total, F.G, F.vcu}; pg8::EpiMoe2 E{GY, tabA, tabF};
        pg8::gemm_phase<pg8::EpiMoe2, pg8::MoeOrder<false>, true, true>(F.lds + RING_OFF, HID, (const bf16*)(F.ws + WS_W2), DE, So, E);
        SHADOW_CVT(false, 1, 0, W13_IN_P6); } PH_END(6); SEAM(6);
    PH_BEGIN(7); if (IN(7)) { combine0_phase(F); } PH_END(7); SEAM(7);
    PH_BEGIN(8); if (IN(8)) { for (int sq = F.vcu; sq < NB * H; sq += F.G) cumsum_seq(F, sq);
        if (cvt_first) { cvt_slice<false>(F, 1, W13_IN_P6, NE * 256, gw_all, nw_all); __syncthreads(); }
        pg8::DenseOrder So; So.init(T, 4 * D, F.G, (int)blockIdx.x); pg8::EpiKVQG E{KB, RSTD, F.in[11], F.in[14]};
        pg8::gemm_phase<pg8::EpiKVQG, pg8::DenseOrder, true, true>(F.lds + RING_OFF, XB, (const bf16*)(F.ws + WS_WKVQG), D, So, E);
        if (!cvt_first) cvt_slice<false>(F, 1, W13_IN_P6, NE * 256, gw_all, nw_all); } PH_END(8); SEAM(8);
    PH_BEGIN(9); if (IN(9)) { float gq = fabsf(F.in[14][F.lane]), gk = fabsf(F.in[11][F.lane]);
#pragma unroll
        for (int o = 1; o < 64; o <<= 1) { gq = fmaxf(gq, __shfl_xor(gq, o)); gk = fmaxf(gk, __shfl_xor(gk, o)); }
        const float TH = 104.f + 16.f * gq * gk * 1.02f + 4.f;
        const attn_body::AttnTensors AT{(const attn_body::bf16*)QB, (const attn_body::bf16*)KB, (const attn_body::bf16*)VB, (const attn_body::bf16*)GB, (const float*)(F.ws + WS_CUM), TH, (attn_body::bf16*)QB};
        const attn_body::StaticOrder Sa((int)F.G, (int)blockIdx.x);
        attn_body::attn_phase<attn_body::StaticOrder>((char*)lds + RING_OFF, AT, Sa); } PH_END(9); SEAM(9);
    PH_BEGIN(10); if (IN(10)) { pg8::DenseOrder So; So.init(T, D, F.G, (int)blockIdx.x); pg8::EpiRes E{F.out, F.out, XB};
        pg8::gemm_phase<pg8::EpiRes, pg8::DenseOrder, true, true>(F.lds + RING_OFF, QB, (const bf16*)(F.ws + WS_WO), D, So, E); } PH_END(10); SEAM(10);
    PH_BEGIN(11); if (IN(11)) { route_phase(F, 1); } PH_END(11); SEAM(11);
    PH_BEGIN(12); if (IN(12)) { const int total = moe_setup<true>(F, 1, F.G, F.vcu); pg8::MoeOrder<true> So{mt, hb, tabA, total, F.G, F.vcu}; pg8::EpiMoe1 E{HID, tabF};
        pg8::gemm_phase<pg8::EpiMoe1, pg8::MoeOrder<true>, true, true>(F.lds + RING_OFF, XB, (const bf16*)(F.ws + WS_W13), D, So, E);
        SHADOW_CVT(true, 1, 0, NE * 128); } PH_END(12); SEAM(12);
    PH_BEGIN(13); if (IN(13)) { const int total = moe_setup<false>(F, 1, F.G, F.vcu); pg8::MoeOrder<false> So{mt, hb, tabA, total, F.G, F.vcu}; pg8::EpiMoe2 E{GY, tabA, tabF};
        pg8::gemm_phase<pg8::EpiMoe2, pg8::MoeOrder<false>, true, true>(F.lds + RING_OFF, HID, (const bf16*)(F.ws + WS_W2), DE, So, E); } PH_END(13); SEAM(13);
    PH_BEGIN(14); if (IN(14)) { final_phase(F); } PH_END(14);
#ifdef EXTRA_BARS
    for (int xb_ = 0; xb_ < EXTRA_BARS; ++xb_) GRID_BAR();
#endif
#undef IN
#undef SEAM
}


#if DBG
namespace nv {

__global__ void rmsnorm(const float* x, int ldx, const float* g, float* y, int ldy, int W) {
    const int r = blockIdx.x; const float* xr = x + (size_t)r * ldx;
    float s = 0.f; for (int c = threadIdx.x; c < W; c += 256) { const float v = xr[c]; s += v * v; }
    __shared__ float red[256]; red[threadIdx.x] = s; __syncthreads();
    for (int o = 128; o > 0; o >>= 1) { if ((int)threadIdx.x < o) red[threadIdx.x] += red[threadIdx.x + o]; __syncthreads(); }
    const float rs = rsqrtf(red[0] / (float)W + EPS);
    for (int c = threadIdx.x; c < W; c += 256) y[(size_t)r * ldy + c] = xr[c] * rs * g[c];
}
__global__ void headnorm(float* x, int ld, const float* g) {
    const int r = blockIdx.x, c = threadIdx.x; float v = x[(size_t)r * ld + c]; float s = v * v;
    for (int o = 1; o < 64; o <<= 1) s += __shfl_xor(s, o);
    x[(size_t)r * ld + c] = v * rsqrtf(s / 64.f + EPS) * g[c & 63];
}
__device__ __forceinline__ float gelu_tanh(float v) { return 0.5f * v * (1.f + tanhf(0.7978845608028654f * (v + 0.044715f * v * v * v))); }
template <int MODE> __global__ void gemm(const float* A, int lda, const float* Bm, int ldb, float* C, int ldc, const float* bias, const float* R, int ldr, int M, int N, int K) {
    __shared__ float As[16][68], Bs[16][68];
    const int tx = threadIdx.x % 16, ty = threadIdx.x / 16, m0 = blockIdx.y * 64, n0 = blockIdx.x * 64;
    float acc[4][4] = {};
    for (int k0 = 0; k0 < K; k0 += 16) {
        for (int i = threadIdx.x; i < 1024; i += 256) { const int m = i / 16, k = i % 16; As[k][m] = A[(size_t)(m0 + m) * lda + k0 + k]; }
        for (int i = threadIdx.x; i < 1024; i += 256) { const int k = i / 64, n = i % 64; Bs[k][n] = (n0 + n < N) ? Bm[(size_t)(k0 + k) * ldb + n0 + n] : 0.f; }
        __syncthreads();
#pragma unroll
        for (int k = 0; k < 16; ++k) {
            float a[4], b[4];
#pragma unroll
            for (int i = 0; i < 4; ++i) { a[i] = As[k][ty * 4 + i]; b[i] = Bs[k][tx * 4 + i]; }
#pragma unroll
            for (int i = 0; i < 4; ++i)
#pragma unroll
                for (int j = 0; j < 4; ++j) acc[i][j] += a[i] * b[j];
        }
        __syncthreads();
    }
    for (int i = 0; i < 4; ++i) for (int j = 0; j < 4; ++j) {
        const int m = m0 + ty * 4 + i, n = n0 + tx * 4 + j; if (n >= N) continue;
        float v = acc[i][j]; if (bias) v += bias[n]; if (MODE == 1) v = gelu_tanh(v); if (MODE == 2) v += R[(size_t)m * ldr + n];
        C[(size_t)m * ldc + n] = v;
    }
}
__global__ void sgu(const float* z, const float* w_s, const float* b_s, float* gated) {
    const int c = blockIdx.x * 256 + threadIdx.x, t = blockIdx.y, g = c / 256, blk = t / 128, tt = t % 128;
    const float* W = w_s + ((size_t)g * 128 + tt) * 128; float acc = 0.f; const int smax = (tt < 64) ? 64 : 128;
    for (int s = 0; s < smax; ++s) acc += W[s] * z[(size_t)(blk * 128 + s) * ZW + SW + c];
    gated[(size_t)t * SW + c] = z[(size_t)t * ZW + c] * (acc + b_s[g * 128 + tt]);
}
__global__ void route(const float* xn, const float* wg, const float* bg, const float* we, const float* be, int* eid, float* ew) {
    const int t = blockIdx.x, l = threadIdx.x; __shared__ float part[64][37]; __shared__ float lg[36];
    float a[36]; for (int j = 0; j < 36; ++j) a[j] = 0.f;
    for (int k = l; k < D; k += 64) { const float xv = xn[(size_t)t * D + k];
        for (int j = 0; j < 32; ++j) a[j] += xv * we[(size_t)k * NE + j];
        for (int j = 0; j < 4; ++j) a[32 + j] += xv * wg[(size_t)k * NG + j]; }
    for (int j = 0; j < 36; ++j) part[l][j] = a[j];
    __syncthreads();
    if (l < 36) { float s = 0.f; for (int i = 0; i < 64; ++i) s += part[i][l]; lg[l] = s + (l < 32 ? be[l] : bg[l - 32]); }
    __syncthreads();
    if (l == 0) {
        int gs = 0; float gm = lg[32]; for (int j = 1; j < 4; ++j) if (lg[32 + j] > gm) { gm = lg[32 + j]; gs = j; }
        float gsum = 0.f; for (int j = 0; j < 4; ++j) gsum += expf(lg[32 + j] - gm); const float gw = 1.f / gsum;
        const float* el = lg + gs * EPG; int i0 = 0; for (int j = 1; j < EPG; ++j) if (el[j] > el[i0]) i0 = j;
        int i1 = (i0 == 0) ? 1 : 0; for (int j = 0; j < EPG; ++j) if (j != i0 && el[j] > el[i1]) i1 = j;
        const float p1 = expf(el[i1] - el[i0]); const float w0 = 1.f / (1.f + p1), w1 = p1 / (1.f + p1);
        eid[2 * t] = gs * EPG + i0; eid[2 * t + 1] = gs * EPG + i1; ew[2 * t] = gw * w0; ew[2 * t + 1] = gw * w1;
    }
}
__global__ void moe_ffn(const float* xn, const float* xres, const int* eid, const float* ew, const float* w1, const float* w3, const float* w2, float* out) {
    __shared__ float xs[1024], hs[512]; const int t = blockIdx.x, tid = threadIdx.x;
    for (int i = tid; i < D; i += 256) xs[i] = xn[(size_t)t * D + i];
    float o[4] = {0.f, 0.f, 0.f, 0.f}; __syncthreads();
    for (int k = 0; k < 2; ++k) { const int e = eid[2 * t + k]; const float w = ew[2 * t + k];
        const float* W1 = w1 + (size_t)e * D * DE; const float* W3 = w3 + (size_t)e * D * DE; const float* W2 = w2 + (size_t)e * DE * D;
        for (int j = tid; j < DE; j += 256) { float a = 0.f, b = 0.f; for (int kk = 0; kk < D; ++kk) { a += xs[kk] * W1[(size_t)kk * DE + j]; b += xs[kk] * W3[(size_t)kk * DE + j]; }
            hs[j] = a / (1.f + expf(-a)) * b; }
        __syncthreads();
        for (int i = 0; i < 4; ++i) { const int n = tid + 256 * i; float y = 0.f; for (int j = 0; j < DE; ++j) y += hs[j] * W2[(size_t)j * D + n]; o[i] += w * y; }
        __syncthreads(); }
    for (int i = 0; i < 4; ++i) { const int n = tid + 256 * i; out[(size_t)t * D + n] = xres[(size_t)t * D + n] + o[i]; }
}
__global__ void logf_k(const float* kvf, const float* bf, float* lf) {
    const int i = blockIdx.x * 256 + threadIdx.x, t = i / H, h = i % H; const float f = kvf[(size_t)t * KVW + 2 * D + h] + bf[h];
    lf[i] = fminf(f, 0.f) - log1pf(expf(-fabsf(f)));
}
__global__ void cumsum_k(const float* lf, float* cum, int n) {
    const int h = threadIdx.x; if (h >= H) return; double s = 0.0; for (int t = 0; t < n; ++t) { s += (double)lf[t * H + h]; cum[h * S + t] = (float)s; }
}
__global__ void attn(const float* qg, const float* kvf, const float* cum, float* ao) {
    const int t = blockIdx.x, h = blockIdx.y, d = threadIdx.x; const float qd = qg[(size_t)t * 2 * D + h * HD + d]; const float ct = cum[h * S + t];
    float m = -INFINITY, l = 0.f, acc = 0.f;
    for (int s = 0; s <= t; ++s) { float p = qd * kvf[(size_t)s * KVW + h * HD + d];
        for (int o = 1; o < 64; o <<= 1) p += __shfl_xor(p, o);
        const float sc = p * 0.125f + ct - cum[h * S + s]; const float mn = fmaxf(m, sc), f = expf(m - mn), e = expf(sc - mn);
        l = l * f + e; acc = acc * f + e * kvf[(size_t)s * KVW + D + h * HD + d]; m = mn; }
    const float gt = qg[(size_t)t * 2 * D + D + h * HD + d];
    ao[(size_t)t * D + h * HD + d] = acc / l / (1.f + expf(-gt));
}
}
namespace nv {
struct Bufs { float *hbuf, *z, *gated, *kvf, *qg, *ao, *lf, *cum; int* eid; float* ew; };
__host__ inline Bufs carve(char* base) { const size_t M = 1u << 20; Bufs b; b.hbuf = (float*)(base); b.z = (float*)(base + 16 * M); b.gated = (float*)(base + 80 * M); b.kvf = (float*)(base + 112 * M);
    b.qg = (float*)(base + 146 * M); b.ao = (float*)(base + 178 * M); b.lf = (float*)(base + 194 * M); b.cum = (float*)(base + 195 * M); b.eid = (int*)(base + 196 * M); b.ew = (float*)(base + 197 * M); return b; }
__host__ inline Bufs carve_small(char* base) { const size_t M = 1u << 20; Bufs b; b.hbuf = (float*)(base); b.z = (float*)(base + 4 * M); b.gated = (float*)(base + 20 * M); b.kvf = (float*)(base + 28 * M);
    b.qg = (float*)(base + 37 * M); b.ao = (float*)(base + 45 * M); b.lf = (float*)(base + 49 * M); b.cum = (float*)(base + 50 * M); b.eid = (int*)(base + 51 * M); b.ew = (float*)(base + 52 * M); return b; }
__global__ void sigm_k(const float* qg, float* o) { const int i = blockIdx.x * 256 + threadIdx.x, t = i / D, c = i % D; o[i] = 1.f / (1.f + expf(-qg[(size_t)t * 2 * D + D + c])); }
inline void run_batch(void* const* d_in, const float* xb, float* ob, const Bufs& B, int n, hipStream_t st, float* const* snap, int* const* seid, float* const* sew) {
    const float* a_norm = (const float*)d_in[1]; const float* a_w_in = (const float*)d_in[2]; const float* a_b_in = (const float*)d_in[3];
    const float* a_v_norm = (const float*)d_in[4]; const float* a_w_s = (const float*)d_in[5]; const float* a_b_s = (const float*)d_in[6]; const float* a_w_out = (const float*)d_in[7];
    const float* kv_norm = (const float*)d_in[8]; const float* kv_w = (const float*)d_in[9]; const float* kv_b_f = (const float*)d_in[10]; const float* k_norm = (const float*)d_in[11];
    const float* b_norm = (const float*)d_in[12]; const float* b_w_qg = (const float*)d_in[13]; const float* q_norm = (const float*)d_in[14]; const float* b_w_out = (const float*)d_in[15];
    const float* m_norm = (const float*)d_in[16]; const float* m_w_group = (const float*)d_in[17]; const float* m_b_group = (const float*)d_in[18]; const float* m_w_expert = (const float*)d_in[19];
    const float* m_b_expert = (const float*)d_in[20]; const float* m_w1 = (const float*)d_in[21]; const float* m_w3 = (const float*)d_in[22]; const float* m_w2 = (const float*)d_in[23];
    const size_t rowb = (size_t)n * D * 4;
    rmsnorm<<<n, 256, 0, st>>>(xb, D, a_norm, B.hbuf, D, D);
    gemm<1><<<dim3(ZW / 64, n / 64), 256, 0, st>>>(B.hbuf, D, a_w_in, ZW, B.z, ZW, a_b_in, nullptr, 0, n, ZW, D);
    rmsnorm<<<n, 256, 0, st>>>(B.z + SW, ZW, a_v_norm, B.z + SW, ZW, SW);
    sgu<<<dim3(SW / 256, n), 256, 0, st>>>(B.z, a_w_s, a_b_s, B.gated);
    gemm<2><<<dim3(D / 64, n / 64), 256, 0, st>>>(B.gated, SW, a_w_out, D, ob, D, nullptr, xb, D, n, D, SW);
    if (snap) (void)hipMemcpyAsync(snap[0], ob, rowb, hipMemcpyDeviceToDevice, st);
    rmsnorm<<<n, 256, 0, st>>>(ob, D, m_norm, B.hbuf, D, D);
    route<<<n, 64, 0, st>>>(B.hbuf, m_w_group, m_b_group, m_w_expert, m_b_expert, B.eid, B.ew);
    if (seid) { (void)hipMemcpyAsync(seid[0], B.eid, (size_t)n * 8, hipMemcpyDeviceToDevice, st); (void)hipMemcpyAsync(sew[0], B.ew, (size_t)n * 8, hipMemcpyDeviceToDevice, st); }
    moe_ffn<<<n, 256, 0, st>>>(B.hbuf, ob, B.eid, B.ew, m_w1, m_w3, m_w2, ob);
    if (snap) (void)hipMemcpyAsync(snap[1], ob, rowb, hipMemcpyDeviceToDevice, st);
    rmsnorm<<<n, 256, 0, st>>>(ob, D, kv_norm, B.hbuf, D, D);
    gemm<0><<<dim3((KVW + 63) / 64, n / 64), 256, 0, st>>>(B.hbuf, D, kv_w, KVW, B.kvf, KVW, nullptr, nullptr, 0, n, KVW, D);
    headnorm<<<n, 1024, 0, st>>>(B.kvf, KVW, k_norm);
    logf_k<<<n * H / 256, 256, 0, st>>>(B.kvf, kv_b_f, B.lf);
    cumsum_k<<<1, 64, 0, st>>>(B.lf, B.cum, n);
    rmsnorm<<<n, 256, 0, st>>>(ob, D, b_norm, B.hbuf, D, D);
    gemm<0><<<dim3(2 * D / 64, n / 64), 256, 0, st>>>(B.hbuf, D, b_w_qg, 2 * D, B.qg, 2 * D, nullptr, nullptr, 0, n, 2 * D, D);
    headnorm<<<n, 1024, 0, st>>>(B.qg, 2 * D, q_norm);
    attn<<<dim3(n, H), 64, 0, st>>>(B.qg, B.kvf, B.cum, B.ao);
    gemm<2><<<dim3(D / 64, n / 64), 256, 0, st>>>(B.ao, D, b_w_out, D, ob, D, nullptr, ob, D, n, D, D);
    if (snap) (void)hipMemcpyAsync(snap[2], ob, rowb, hipMemcpyDeviceToDevice, st);
    rmsnorm<<<n, 256, 0, st>>>(ob, D, m_norm + D, B.hbuf, D, D);
    route<<<n, 64, 0, st>>>(B.hbuf, m_w_group + D * NG, m_b_group + NG, m_w_expert + D * NE, m_b_expert + NE, B.eid, B.ew);
    if (seid) { (void)hipMemcpyAsync(seid[1], B.eid, (size_t)n * 8, hipMemcpyDeviceToDevice, st); (void)hipMemcpyAsync(sew[1], B.ew, (size_t)n * 8, hipMemcpyDeviceToDevice, st); }
    moe_ffn<<<n, 256, 0, st>>>(B.hbuf, ob, B.eid, B.ew, m_w1 + (size_t)NE * D * DE, m_w3 + (size_t)NE * D * DE, m_w2 + (size_t)NE * DE * D, ob);
    if (snap) (void)hipMemcpyAsync(snap[3], ob, rowb, hipMemcpyDeviceToDevice, st);
}
template <bool BF> __global__ void cmp_k(const void* fast, int ldf, const float* naive, int ldn, int cols, float nscale, float* err, int slot) {
    const int r = blockIdx.x; float d2 = 0.f, n2 = 0.f;
    for (int c = threadIdx.x; c < cols; c += 256) { float f; if (BF) { const unsigned short w = ((const unsigned short*)fast)[(size_t)r * ldf + c]; f = __uint_as_float((unsigned)w << 16); } else f = ((const float*)fast)[(size_t)r * ldf + c];
        const float nv_ = naive[(size_t)r * ldn + c] * nscale; float d = f - nv_; if (!(d == d) || fabsf(d) > 1e30f) d = 1e15f; d2 += d * d; n2 += nv_ * nv_; }
    for (int o = 1; o < 64; o <<= 1) { d2 += __shfl_xor(d2, o); n2 += __shfl_xor(n2, o); }
    if ((threadIdx.x & 63) == 0) { atomicAdd(err + 2 * slot, d2); atomicAdd(err + 2 * slot + 1, n2); }
}
__global__ void cmp_route(const int* LA, const float* LW, const unsigned* cnt  , const int* eid, const float* ew, int tok0, int n, float* err, int slot) {
    const int i = blockIdx.x * 64 + threadIdx.x; if (i >= 2 * n) return; const int e = eid[i]; const int a = 2 * tok0 + i; const int c = (int)cnt[e * 64]; bool ok = false;
    for (int p = 0; p < c && p < LCAP; ++p) if (LA[(size_t)e * LCAP + p] == a) { ok = fabsf(LW[(size_t)e * LCAP + p] - ew[i]) <= 0.02f * fabsf(ew[i]) + 1e-4f; break; }
    atomicAdd(err + 2 * slot, ok ? 0.f : 1.f); atomicAdd(err + 2 * slot + 1, 1.f);
}
__global__ void encode_k(float* out, const float* nout, const float* err, int nslot, float tol) {
    int f = -1; for (int s = 0; s < nslot; ++s) { const float d = err[2 * s], n = err[2 * s + 1]; const float tl = (s == 3 || s == 13) ? 0.03f : tol; if (!(n > 0.f) || !(d <= tl * n)) { f = s; break; } }
    if (f < 0) return; const float k = 1.f + 0.1f * (float)(f + 1);
    for (size_t i = (size_t)blockIdx.x * 256 + threadIdx.x; i < (size_t)T * D; i += (size_t)gridDim.x * 256) out[i] = nout[i] * k;
}
}
#endif
#if DBG
#ifndef DBG_NCHK
#define DBG_NCHK 1024
#endif
#ifndef DBG_CB
#define DBG_CB 0
#endif
static_assert(MK_PER_PHASE == 1, "DBG needs one launch per phase");
namespace nv {
struct Ctx { hipStream_t st; float* out; char* ws; Bufs Bw; float* snap[4]; int* seid[2]; float* sew[2]; float* sgate; float* err; } g;
inline void after(int p) {
    const int n = DBG_NCHK; const size_t tok0 = (size_t)DBG_CB * S; hipStream_t st = g.st; char* ws = g.ws;
    const unsigned short* ZB = (const unsigned short*)(ws + WS_BIG); const unsigned short* GY = (const unsigned short*)(ws + WS_GY); const unsigned short* XB = (const unsigned short*)(ws + WS_XB);
    const unsigned short* KB = ZB; const unsigned short* VB = ZB + (size_t)T * D; const unsigned short* QB = ZB + (size_t)2 * T * D; const unsigned short* GB = ZB + (size_t)3 * T * D;
    const int* LA = (const int*)(ws + WS_LA); const float* LW = (const float*)(ws + WS_LW); const unsigned* cnt = (const unsigned*)(ws + WS_CTL) + CW_CNT;
    if (p == 1) cmp_k<true><<<n, 256, 0, st>>>(ZB + tok0 * ZW, ZW, g.Bw.z, ZW, SW, 1.f, g.err, 0);
    if (p == 2) cmp_k<true><<<n, 256, 0, st>>>(GY + tok0 * SW, SW, g.Bw.gated, SW, SW, 1.f, g.err, 1);
    if (p == 3) cmp_k<false><<<n, 256, 0, st>>>(g.out + tok0 * D, D, g.snap[0], D, D, 1.f, g.err, 2);
    if (p == 4) cmp_route<<<(2 * n + 63) / 64, 64, 0, st>>>(LA, LW, cnt, g.seid[0], g.sew[0], (int)tok0, n, g.err, 3);
    if (p == 7) { cmp_k<false><<<n, 256, 0, st>>>(g.out + tok0 * D, D, g.snap[1], D, D, 1.f, g.err, 4); cmp_k<true><<<n, 256, 0, st>>>(XB + tok0 * D, D, g.snap[1], D, D, 1.f, g.err, 5); }
    if (p == 8) { cmp_k<true><<<n, 256, 0, st>>>(KB + tok0 * D, D, g.Bw.kvf, KVW, D, 1.f, g.err, 6); cmp_k<true><<<n, 256, 0, st>>>(VB + tok0 * D, D, g.Bw.kvf + D, KVW, D, 1.f, g.err, 7);
        cmp_k<true><<<n, 256, 0, st>>>(QB + tok0 * D, D, g.Bw.qg, 2 * D, D, 0.125f * LOG2E, g.err, 8); cmp_k<true><<<n, 256, 0, st>>>(GB + tok0 * D, D, g.sgate, D, D, 1.f, g.err, 9);
        cmp_k<false><<<H, 256, 0, st>>>((const float*)(ws + WS_CUM) + (size_t)DBG_CB * H * S, S, g.Bw.cum, S, n, 1.f, g.err, 10); }
    if (p == 9) cmp_k<true><<<n, 256, 0, st>>>(QB + tok0 * D, D, g.Bw.ao, D, D, 1.f, g.err, 11);
    if (p == 10) cmp_k<false><<<n, 256, 0, st>>>(g.out + tok0 * D, D, g.snap[2], D, D, 1.f, g.err, 12);
    if (p == 11) cmp_route<<<(2 * n + 63) / 64, 64, 0, st>>>(LA, LW, cnt + 32 * 64, g.seid[1], g.sew[1], (int)tok0, n, g.err, 13);
    if (p == 14) cmp_k<false><<<n, 256, 0, st>>>(g.out + tok0 * D, D, g.snap[3], D, D, 1.f, g.err, 14);
}
}
#undef DBG_AFTER_PHASE
#define DBG_AFTER_PHASE(p) nv::after(p)
#define DBG_BEGIN() do { const size_t M_ = 1u << 20; char* db = (char*)d_ws + 400 * M_; nv::g.st = stream; nv::g.out = (float*)d_out; nv::g.ws = (char*)d_ws; nv::g.Bw = nv::carve_small(db); \
    for (int i_ = 0; i_ < 4; ++i_) nv::g.snap[i_] = (float*)(db + (56 + 4 * i_) * M_); nv::g.seid[0] = (int*)(db + 72 * M_); nv::g.seid[1] = (int*)(db + 73 * M_); nv::g.sew[0] = (float*)(db + 74 * M_); nv::g.sew[1] = (float*)(db + 75 * M_); \
    nv::g.sgate = (float*)(db + 76 * M_); float* wout_ = (float*)(db + 80 * M_); nv::g.err = (float*)(db + 84 * M_); (void)hipMemsetAsync(nv::g.err, 0, 4096, stream); \
    nv::run_batch(d_in, (const float*)d_in[0] + (size_t)DBG_CB * S * D, wout_, nv::g.Bw, DBG_NCHK, stream, nv::g.snap, nv::g.seid, nv::g.sew); \
    nv::sigm_k<<<DBG_NCHK * D / 256, 256, 0, stream>>>(nv::g.Bw.qg, nv::g.sgate); } while (0)
#define DBG_END() do { const size_t M_ = 1u << 20; nv::Bufs Bf = nv::carve((char*)d_ws + 2 * M_); float* nout = (float*)((char*)d_ws + 300 * M_); \
    for (int b_ = 0; b_ < NB; ++b_) nv::run_batch(d_in, (const float*)d_in[0] + (size_t)b_ * S * D, nout + (size_t)b_ * S * D, Bf, S, stream, nullptr, nullptr, nullptr); \
    nv::encode_k<<<1024, 256, 0, stream>>>((float*)d_out, nout, nv::g.err, 15, 2e-3f); } while (0)
#else
#define DBG_BEGIN() do { } while (0)
#define DBG_END() do { } while (0)
#endif
extern "C" void kernel_launch(void* const* d_in, const int* in_sizes, int n_in, void* d_out, int out_size, void* d_ws, size_t ws_size, hipStream_t stream) {
    static int grid = 0;
    if (grid == 0) {
        if (n_in != 24 || out_size != T * D || ws_size < WS_END) { grid = -1; return; }
        int dev = 0, cus = 0;
        if (hipGetDevice(&dev) != hipSuccess || hipDeviceGetAttribute(&cus, hipDeviceAttributeMultiprocessorCount, dev) != hipSuccess) { grid = -1; return; }
        if (hipFuncSetAttribute((const void*)fwd, hipFuncAttributeMaxDynamicSharedMemorySize, LDS_BYTES) != hipSuccess) { grid = -1; return; }
        int per_cu = 0; (void)hipOccupancyMaxActiveBlocksPerMultiprocessor(&per_cu, (const void*)fwd, NWAVES * 64, LDS_BYTES); (void)hipGetLastError();
        grid = cus;
    }
    if (grid < 0) return;
    (void)hipMemsetAsync((char*)d_ws + WS_CTL, 0, CTL_ZERO_BYTES, stream);
    DBG_BEGIN();
    Args a{};
    for (int i = 0; i < 24; ++i) a.in[i] = (const float*)d_in[i];
    a.out = (float*)d_out; a.ws = (unsigned char*)d_ws;
#if MK_PER_PHASE
    for (int p = 0; p < NPH; ++p) { a.ph_lo = p; a.ph_hi = p + 1; hipLaunchKernelGGL(fwd, dim3(grid), dim3(NWAVES * 64), LDS_BYTES, stream, a); DBG_AFTER_PHASE(p); }
    DBG_END();
#else
    a.ph_lo = 0; a.ph_hi = NPH; hipLaunchKernelGGL(fwd, dim3(grid), dim3(NWAVES * 64), LDS_BYTES, stream, a);
#endif
}
```
